# Optimizing an MI355X kernel written in HIP

```python
import jax, jax.numpy as jnp
from jax import lax
import numpy as np

D_MODEL = 2048
BATCH = 8
SEQ = 2048
DEPTH = 2

D_MIX = D_MODEL
HEAD_DIM = 64
ATTN_WIDTH = D_MIX // 2
N_Q_HEADS = ATTN_WIDTH // HEAD_DIM
N_KV_HEADS = N_Q_HEADS // 4
KV_WIDTH = N_KV_HEADS * HEAD_DIM
WINDOW = 128
CONV_WIDTH = D_MIX // 4
CONV_KERNEL = 31
SGU_WIDTH = D_MIX // 4
SGU_HEADS = SGU_WIDTH // HEAD_DIM
CHUNK = 128
D_FF = 4 * D_MODEL
EPS = 1e-6
NEG_INF = -1e30
SPLITS = (ATTN_WIDTH,
          ATTN_WIDTH + KV_WIDTH,
          ATTN_WIDTH + 2 * KV_WIDTH,
          ATTN_WIDTH + 2 * KV_WIDTH + 2 * CONV_WIDTH)
D_IN = ATTN_WIDTH + 2 * KV_WIDTH + 2 * CONV_WIDTH + 2 * SGU_WIDTH

kernel_name = "hymba_conv_sgu_swa_hybrid"


def rms_norm(x, g):
    xf = x.astype(jnp.float32)
    y = xf * lax.rsqrt(jnp.mean(xf * xf, axis=-1, keepdims=True) + EPS)
    return (y * g.astype(jnp.float32)).astype(x.dtype)


def layer_norm(x, g, b):
    xf = x.astype(jnp.float32)
    mu = jnp.mean(xf, axis=-1, keepdims=True)
    xc = xf - mu
    y = xc * lax.rsqrt(jnp.mean(xc * xc, axis=-1, keepdims=True) + EPS)
    return (y * g.astype(jnp.float32) + b.astype(jnp.float32)).astype(x.dtype)


def sliding_window_attention(q, k, v, sinks):
    B, S = q.shape[0], q.shape[1]
    nb = S // WINDOW
    G = N_Q_HEADS // N_KV_HEADS
    qb = q.reshape(B, nb, WINDOW, N_KV_HEADS, G, HEAD_DIM)

    def with_prev(t):
        tb = t.reshape(B, nb, WINDOW, N_KV_HEADS, HEAD_DIM)
        prev = jnp.pad(tb, ((0, 0), (1, 0), (0, 0), (0, 0), (0, 0)))[:, :-1]
        return jnp.concatenate([prev, tb], axis=2)

    kb, vb = with_prev(k), with_prev(v)
    scale = HEAD_DIM ** -0.5
    logits = jnp.einsum('bnqkgd,bnskd->bnkgqs', qb, kb).astype(jnp.float32) * scale
    qi = jnp.arange(WINDOW)[None, :, None]
    sj = jnp.arange(2 * WINDOW)[None, None, :]
    blk = jnp.arange(nb)[:, None, None]
    rel = qi + WINDOW - sj
    key_pos = blk * WINDOW - WINDOW + sj
    mask = (rel >= 0) & (rel < WINDOW) & (key_pos >= 0)
    logits = jnp.where(mask[None, :, None, None], logits, NEG_INF)
    sink = sinks.astype(jnp.float32).reshape(N_KV_HEADS, G)[None, None, :, :, None, None]
    m = jnp.maximum(jnp.max(logits, axis=-1, keepdims=True), sink)
    p = jnp.exp(logits - m)
    denom = jnp.sum(p, axis=-1, keepdims=True) + jnp.exp(sink - m)
    probs = (p / denom).astype(v.dtype)
    out = jnp.einsum('bnkgqs,bnskd->bnqkgd', probs, vb)
    return out.reshape(B, S, ATTN_WIDTH)


def conv_module(xc, conv_w, conv_b, ln_g, ln_b):
    a, gate = jnp.split(xc, 2, axis=-1)
    h = a * jax.nn.sigmoid(gate)
    h = lax.conv_general_dilated(
        h, conv_w[:, None, :].astype(h.dtype), window_strides=(1,),
        padding=[(CONV_KERNEL - 1, 0)],
        dimension_numbers=('NWC', 'WIO', 'NWC'),
        feature_group_count=CONV_WIDTH) + conv_b
    h = layer_norm(h, ln_g, ln_b)
    return jax.nn.silu(h)


def spatial_gating(xs, ln_g, ln_b, w_s, b_s):
    B, S = xs.shape[0], xs.shape[1]
    u, v = jnp.split(xs, 2, axis=-1)
    v = layer_norm(v, ln_g, ln_b)
    vb = v.reshape(B, S // CHUNK, CHUNK, SGU_HEADS, HEAD_DIM)
    causal = jnp.tril(jnp.ones((CHUNK, CHUNK), dtype=bool))
    w = jnp.where(causal[None], w_s, jnp.zeros_like(w_s))
    s = jnp.einsum('hij,bnjhd->bnihd', w, vb) + b_s.T[None, None, :, :, None]
    return u * s.reshape(B, S, SGU_WIDTH)


def setup_inputs(seed: int = 0) -> dict:
    key = jax.random.key(seed)
    ks = jax.random.split(key, 20)
    f32 = jnp.float32

    def nrm(k, shape, scale):
        return jax.random.normal(k, shape, f32) * scale

    def gain(k, shape):
        return 1.0 + 0.02 * jax.random.normal(k, shape, f32)

    return {
        "x": jax.random.normal(ks[0], (BATCH, SEQ, D_MODEL), f32),
        "ln1_g": gain(ks[1], (DEPTH, D_MODEL)),
        "w_in": nrm(ks[2], (DEPTH, D_MODEL, D_IN), D_MODEL ** -0.5),
        "q_norm_g": gain(ks[3], (DEPTH, HEAD_DIM)),
        "k_norm_g": gain(ks[4], (DEPTH, HEAD_DIM)),
        "sinks": nrm(ks[5], (DEPTH, N_Q_HEADS), 0.5),
        "conv_w": nrm(ks[6], (DEPTH, CONV_KERNEL, CONV_WIDTH), CONV_KERNEL ** -0.5),
        "conv_b": nrm(ks[7], (DEPTH, CONV_WIDTH), 0.02),
        "conv_ln_g": gain(ks[8], (DEPTH, CONV_WIDTH)),
        "conv_ln_b": nrm(ks[9], (DEPTH, CONV_WIDTH), 0.02),
        "sgu_ln_g": gain(ks[10], (DEPTH, SGU_WIDTH)),
        "sgu_ln_b": nrm(ks[11], (DEPTH, SGU_WIDTH), 0.02),
        "sgu_w": nrm(ks[12], (DEPTH, SGU_HEADS, CHUNK, CHUNK), CHUNK ** -0.5),
        "sgu_b": gain(ks[13], (DEPTH, SGU_HEADS, CHUNK)),
        "out_norm_g": gain(ks[14], (DEPTH, D_MIX)),
        "w_out": nrm(ks[15], (DEPTH, D_MIX, D_MODEL), D_MIX ** -0.5),
        "ln2_g": gain(ks[16], (DEPTH, D_MODEL)),
        "w_up": nrm(ks[17], (DEPTH, D_MODEL, D_FF), D_MODEL ** -0.5),
        "w_down": nrm(ks[18], (DEPTH, D_FF, D_MODEL), D_FF ** -0.5),
    }


def reference(x, ln1_g, w_in, q_norm_g, k_norm_g, sinks, conv_w, conv_b, conv_ln_g,
              conv_ln_b, sgu_ln_g, sgu_ln_b, sgu_w, sgu_b, out_norm_g, w_out, ln2_g,
              w_up, w_down):
    B, S = x.shape[0], x.shape[1]
    for l in range(DEPTH):
        h = rms_norm(x, ln1_g[l])
        proj = h @ w_in[l]
        q, k, v, xc, xs = jnp.split(proj, SPLITS, axis=-1)
        q = rms_norm(q.reshape(B, S, N_Q_HEADS, HEAD_DIM), q_norm_g[l])
        k = rms_norm(k.reshape(B, S, N_KV_HEADS, HEAD_DIM), k_norm_g[l])
        v = v.reshape(B, S, N_KV_HEADS, HEAD_DIM)
        y_attn = sliding_window_attention(q, k, v, sinks[l])
        y_conv = conv_module(xc, conv_w[l], conv_b[l], conv_ln_g[l], conv_ln_b[l])
        y_sgu = spatial_gating(xs, sgu_ln_g[l], sgu_ln_b[l], sgu_w[l], sgu_b[l])
        g = out_norm_g[l]
        mix = jnp.concatenate([
            rms_norm(y_attn, g[:ATTN_WIDTH]),
            rms_norm(y_conv, g[ATTN_WIDTH:ATTN_WIDTH + CONV_WIDTH]),
            rms_norm(y_sgu, g[ATTN_WIDTH + CONV_WIDTH:]),
        ], axis=-1)
        x = x + mix @ w_out[l]
        h = rms_norm(x, ln2_g[l])
        x = x + jnp.square(jax.nn.relu(h @ w_up[l])) @ w_down[l]
    return x
```

```cpp
#include <hip/hip_runtime.h>
#include <hip/hip_cooperative_groups.h>
#include <cstdio>
#include <cstdint>
namespace cg = cooperative_groups;

#ifndef MK_ONE_LAUNCH
#define MK_ONE_LAUNCH 0
#endif

constexpr int DM = 2048, SEQ = 2048, NB = 8, M = NB * SEQ, DIN = 3584, DFF = 8192, DEPTH = 2;
constexpr int C_Q = 0, C_K = 1024, C_V = 1280, C_CA = 1536, C_CG = 2048, C_SU = 2560, C_SV = 3072;
constexpr int X_ATT = 0, X_CONV = 1024, X_SGU = 1536;
constexpr float EPS = 1e-6f;

#define LAS __attribute__((address_space(3)))
typedef unsigned short bf16_t;
typedef short bf16x8 __attribute__((ext_vector_type(8)));
typedef float f32x4 __attribute__((ext_vector_type(4)));
typedef unsigned u32x4 __attribute__((ext_vector_type(4)));
typedef unsigned u32x2 __attribute__((ext_vector_type(2)));

__device__ __forceinline__ unsigned cvt_pk_bf16(float lo, float hi) { unsigned r; asm volatile("v_cvt_pk_bf16_f32 %0, %1, %2" : "=v"(r) : "v"(lo), "v"(hi)); return r; }
__device__ __forceinline__ float bf2f(bf16_t b) { return __uint_as_float(((unsigned)b) << 16); }
__device__ __forceinline__ bf16_t f2bf(float f) { return (bf16_t)(cvt_pk_bf16(f, 0.f) & 0xffffu); }
__device__ __forceinline__ float wave_sum(float v) {
#pragma unroll
    for (int o = 1; o < 64; o <<= 1) v += __shfl_xor(v, o);
    return v;
}
__device__ __forceinline__ float wave_max(float v) {
#pragma unroll
    for (int o = 1; o < 64; o <<= 1) v = fmaxf(v, __shfl_xor(v, o));
    return v;
}

namespace pg8 {
constexpr int BM = 256, BK = 64, HALF = 128, HTB = HALF * BK * 2, STAGE_BYTES = 8 * HTB, NXCD = 8, WGM = 8;
__host__ __device__ __forceinline__ int lds_byte(int r, int c) { const int st = (r >> 4) * 2 + (c >> 5), rr = r & 15, cc = c & 31, ob = rr * 64 + cc * 2; return st * 1024 + (ob ^ (((ob >> 9) & 1) << 5)); }
__host__ __device__ __forceinline__ void stage_rc(int b, int& R, int& C) { const int st = b / 1024, sb = b % 1024, swz = sb ^ (((sb >> 9) & 1) << 5); R = (st >> 1) * 16 + swz / 64; C = (st & 1) * 32 + (swz % 64) / 2; }
__host__ __device__ __forceinline__ int perm32(int rho) { const int n = rho >> 4, i = rho & 15; return 8 * (i >> 2) + 4 * n + (i & 3); }

struct Unit { int pm, pn; };
struct Gemm { const bf16_t* A; const bf16_t* Bt; int M, N, K; };

struct StaticOrder {
    int nM, nN, nwg, G, c;
    __host__ __device__ void init(int M_, int N_, int G_, int c_) { nM = M_ / BM; nN = N_ / BM; nwg = nM * nN; G = G_; c = c_; }
    __host__ __device__ bool next(int i, Unit& u) const {
        const long L = (long)i * G + c; if (L >= nwg) return false;
        int wgid = (int)L; { const int q = nwg / NXCD, r = nwg % NXCD, xcd = wgid % NXCD, off = wgid / NXCD; wgid = (xcd < r ? xcd * (q + 1) : r * (q + 1) + (xcd - r) * q) + off; }
        const int nig = WGM * nN, gid = wgid / nig, fm = gid * WGM, gsz = (nM - fm) < WGM ? (nM - fm) : WGM;
        u.pm = fm + ((wgid % nig) % gsz); u.pn = (wgid % nig) / gsz; return true;
    }
};

template <int ACT> struct EpiScaleBf16 {
    static constexpr bool PERM = true; static constexpr int MID_T = 0;
    bf16_t* O; int ldc; const float* rowss; float inv_n;
    __device__ __forceinline__ void mid(f32x4 (&)[2][2][4][2], const Unit&, int, int) const {}
    __device__ __forceinline__ void operator()(const f32x4 (&acc)[2][2][4][2], const Unit& u, int wr, int wc, int fr, int fq) const {
        const int row0 = u.pm * BM + wr * 64 + fr; const int col0 = u.pn * BM + wc * 32 + 8 * fq;
#pragma unroll
        for (int ai = 0; ai < 2; ++ai)
#pragma unroll
            for (int m = 0; m < 4; ++m) { const int row = row0 + ai * HALF + m * 16; const float rs = rsqrtf(rowss[row] * inv_n + EPS);
                bf16_t* rowp = O + (size_t)row * ldc + col0;
#pragma unroll
                for (int bj = 0; bj < 2; ++bj) { f32x4 v0 = acc[ai][bj][m][0] * rs, v1 = acc[ai][bj][m][1] * rs;
                    if (ACT == 1) {
#pragma unroll
                        for (int e = 0; e < 4; ++e) { float a = fmaxf(v0[e], 0.f), b = fmaxf(v1[e], 0.f); v0[e] = a * a; v1[e] = b * b; } }
                    u32x4 w; w.x = cvt_pk_bf16(v0[0], v0[1]); w.y = cvt_pk_bf16(v0[2], v0[3]); w.z = cvt_pk_bf16(v1[0], v1[1]); w.w = cvt_pk_bf16(v1[2], v1[3]);
                    *(u32x4*)(rowp + bj * HALF) = w; } }
    }
};
template <int MIDT> struct EpiRes {
    static constexpr bool PERM = false; static constexpr int MID_T = MIDT;
    const float* base; float* out; bf16_t* xb; float* rowss_out; const float* astat; int ldc;
    __device__ __forceinline__ void mid(f32x4 (&acc)[2][2][4][2], const Unit& u, int wr, int fr) const {
        const int row0 = u.pm * BM + wr * 64 + fr;
#pragma unroll
        for (int ai = 0; ai < 2; ++ai)
#pragma unroll
            for (int m = 0; m < 4; ++m) { const int row = row0 + ai * HALF + m * 16; const f32x4 s = *(const f32x4*)(astat + (size_t)row * 4);
                const float r1 = rsqrtf(((s[0] + s[1]) + (s[2] + s[3])) * (1.0f / 1024.0f) + EPS);
#pragma unroll
                for (int bj = 0; bj < 2; ++bj)
#pragma unroll
                    for (int n = 0; n < 2; ++n) acc[ai][bj][m][n] = acc[ai][bj][m][n] * r1;
                asm volatile("" ::: "memory"); }
    }
    __device__ __forceinline__ void operator()(const f32x4 (&acc)[2][2][4][2], const Unit& u, int wr, int wc, int fr, int fq) const {
        const int row0 = u.pm * BM + wr * 64 + fr; const int col0 = u.pn * BM + wc * 32 + 4 * fq;
#pragma unroll
        for (int ai = 0; ai < 2; ++ai)
#pragma unroll
            for (int m = 0; m < 4; ++m) { const int row = row0 + ai * HALF + m * 16; const size_t off = (size_t)row * ldc + col0; float ss = 0.f;
#pragma unroll
                for (int bj = 0; bj < 2; ++bj)
#pragma unroll
                    for (int n = 0; n < 2; ++n) { const f32x4 bs = *(const f32x4*)(base + off + bj * HALF + n * 16); const f32x4 o = bs + acc[ai][bj][m][n];
                        *(f32x4*)(out + off + bj * HALF + n * 16) = o;
                        if (xb) { u32x2 w; w.x = cvt_pk_bf16(o[0], o[1]); w.y = cvt_pk_bf16(o[2], o[3]); *(u32x2*)(xb + off + bj * HALF + n * 16) = w; }
                        ss += (o[0] * o[0] + o[1] * o[1]) + (o[2] * o[2] + o[3] * o[3]); }
                if (rowss_out) { ss += __shfl_xor(ss, 16); ss += __shfl_xor(ss, 32); if (fq == 0) atomicAdd(rowss_out + row, ss); }
                if (m & 1) asm volatile("" ::: "memory"); }
    }
};

template <class Epi, bool ALIGN_EPI>
__device__ __forceinline__ void gemm_phase(LAS unsigned char* lds, const Gemm g, const StaticOrder& S, const Epi& E) {
    int tid = threadIdx.x; asm volatile("" : "+v"(tid));
    const int wid = __builtin_amdgcn_readfirstlane(tid >> 6), lane = tid & 63, wr = wid >> 2, wc = wid & 3, fr = lane & 15, fq = lane >> 4;
    const int K = g.K, nt = K / BK;
    unsigned voffA, voffB;
    { int R, C; stage_rc(tid * 16, R, C); const int Rb = Epi::PERM ? ((R & ~31) + perm32(R & 31)) : R; voffA = (unsigned)(R * K + C) * 2u; voffB = (unsigned)(Rb * K + C) * 2u; }
    const size_t r64 = (size_t)64 * K * 2;
    const size_t kstep = (size_t)(BK * 2);
    const size_t hstep = (size_t)HALF * K * 2;
    const size_t tstep = 2 * hstep;
    const unsigned ldsw = (unsigned)wid * 1024u;
    const int aoff = lds_byte(wr * 64 + fr, fq * 8), boff = lds_byte(wc * 32 + fr, fq * 8);
#define PG8_SA(b, h) (((b) * 2 + (h)) * HTB)
#define PG8_SB(b, h) ((4 + (b) * 2 + (h)) * HTB)
#define PG8_STAGE(bufoff, gbase, voff) do { _Pragma("unroll") for (int _i = 0; _i < 2; ++_i) \
        __builtin_amdgcn_global_load_lds((const unsigned*)((const char*)(gbase) + _i * r64 + (voff)), (LAS unsigned*)(lds + (bufoff) + ldsw + _i * 8192), 16, 0, 0); } while (0)
#define PG8_LDA(dst, b, h) do { _Pragma("unroll") for (int m = 0; m < 4; ++m) _Pragma("unroll") for (int k = 0; k < 2; ++k) dst[m][k] = *(const LAS bf16x8*)(lds + PG8_SA(b, h) + aoff + m * 2048 + k * 1024); } while (0)
#define PG8_LDB(dst, b, h) do { _Pragma("unroll") for (int n = 0; n < 2; ++n) _Pragma("unroll") for (int k = 0; k < 2; ++k) dst[n][k] = *(const LAS bf16x8*)(lds + PG8_SB(b, h) + boff + n * 2048 + k * 1024); } while (0)
#define PG8_MMA(ai, bj, At, Bt) do { __builtin_amdgcn_s_setprio(1); _Pragma("unroll") for (int m = 0; m < 4; ++m) _Pragma("unroll") for (int n = 0; n < 2; ++n) _Pragma("unroll") for (int k = 0; k < 2; ++k) \
        acc[ai][bj][m][n] = __builtin_amdgcn_mfma_f32_16x16x32_bf16(Bt[n][k], At[m][k], acc[ai][bj][m][n], 0, 0, 0); __builtin_amdgcn_s_setprio(0); } while (0)
#define PG8_WAIT_V(n) asm volatile("s_waitcnt vmcnt(" #n ")" ::: "memory")
#define PG8_WAIT_L(n) asm volatile("s_waitcnt lgkmcnt(" #n ")" ::: "memory")
#define PG8_BAR __builtin_amdgcn_s_barrier()
#define PG8_SCHED __builtin_amdgcn_sched_barrier(0)
    Unit cur, nxt; int ui = 0;
    if (!S.next(0, cur)) return;
    f32x4 acc[2][2][4][2];
#pragma unroll
    for (int a = 0; a < 2; ++a)
#pragma unroll
        for (int b = 0; b < 2; ++b)
#pragma unroll
            for (int m = 0; m < 4; ++m)
#pragma unroll
                for (int n = 0; n < 2; ++n) acc[a][b][m][n] = (f32x4){0.f, 0.f, 0.f, 0.f};
    bf16x8 At[4][2], B0[2][2], B1[2][2];
    const char* cA = (const char*)g.A + (size_t)cur.pm * tstep; const char* cB = (const char*)g.Bt + (size_t)cur.pn * tstep;
    PG8_STAGE(PG8_SB(0, 0), cB, voffB); PG8_STAGE(PG8_SB(0, 1), cB + hstep, voffB); PG8_STAGE(PG8_SA(0, 0), cA, voffA); PG8_STAGE(PG8_SA(0, 1), cA + hstep, voffA);
    if (wr == 1) PG8_BAR;
    PG8_WAIT_V(2); PG8_BAR;
    PG8_STAGE(PG8_SB(1, 0), cB + kstep, voffB); PG8_STAGE(PG8_SA(1, 0), cA + kstep, voffA); PG8_STAGE(PG8_SB(1, 1), cB + hstep + kstep, voffB);
    PG8_WAIT_V(6); PG8_BAR;
    for (;;) {
        const bool has_next = S.next(ui + 1, nxt);
        const char* nA = has_next ? (const char*)g.A + (size_t)nxt.pm * tstep : cA; const char* nB = has_next ? (const char*)g.Bt + (size_t)nxt.pn * tstep : cB;
        for (int t = 0; t < nt; t += 2) {
            if constexpr (Epi::MID_T > 0) { if (t == Epi::MID_T) E.mid(acc, cur, wr, fr); }
            const bool last = (t == nt - 2);
            const char* a1 = cA + (size_t)(t + 1) * kstep;
            const char* a2 = last ? nA : cA + (size_t)(t + 2) * kstep; const char* b2 = last ? nB : cB + (size_t)(t + 2) * kstep;
            const char* a3 = a2 + kstep; const char* b3 = b2 + kstep;
            PG8_LDB(B0, 0, 0); PG8_LDB(B1, 0, 1); PG8_SCHED; PG8_LDA(At, 0, 0); PG8_STAGE(PG8_SA(1, 1), a1 + hstep, voffA);
            PG8_WAIT_V(8); PG8_WAIT_L(0); PG8_BAR; PG8_MMA(0, 0, At, B0); PG8_MMA(0, 1, At, B1); PG8_BAR; PG8_SCHED;
            PG8_LDA(At, 0, 1); PG8_STAGE(PG8_SB(0, 0), b2, voffB); PG8_STAGE(PG8_SB(0, 1), b2 + hstep, voffB); PG8_STAGE(PG8_SA(0, 0), a2, voffA);
            PG8_WAIT_V(8); PG8_WAIT_L(0); PG8_BAR; PG8_MMA(1, 0, At, B0); PG8_MMA(1, 1, At, B1); PG8_BAR; PG8_SCHED;
            PG8_LDB(B0, 1, 0); PG8_LDB(B1, 1, 1); PG8_SCHED; PG8_LDA(At, 1, 0); PG8_STAGE(PG8_SA(0, 1), a2 + hstep, voffA);
            PG8_WAIT_V(8); PG8_WAIT_L(0); PG8_BAR; PG8_MMA(0, 0, At, B0); PG8_MMA(0, 1, At, B1); PG8_BAR; PG8_SCHED;
            PG8_LDA(At, 1, 1); PG8_STAGE(PG8_SB(1, 0), b3, voffB); PG8_STAGE(PG8_SB(1, 1), b3 + hstep, voffB); PG8_STAGE(PG8_SA(1, 0), a3, voffA);
            PG8_WAIT_V(8); PG8_WAIT_L(0); PG8_BAR; PG8_MMA(1, 0, At, B0); PG8_MMA(1, 1, At, B1); PG8_BAR; PG8_SCHED;
        }
        if constexpr (ALIGN_EPI) { if (wr == 0) PG8_BAR; }
        E(acc, cur, wr, wc, fr, fq);
        if (!has_next) break;
#pragma unroll
        for (int a = 0; a < 2; ++a)
#pragma unroll
            for (int b = 0; b < 2; ++b)
#pragma unroll
                for (int m = 0; m < 4; ++m)
#pragma unroll
                    for (int n = 0; n < 2; ++n) acc[a][b][m][n] = (f32x4){0.f, 0.f, 0.f, 0.f};
        cur = nxt; cA = nA; cB = nB; ++ui;
        if constexpr (ALIGN_EPI) { if (wr == 1) PG8_BAR; }
    }
    PG8_WAIT_V(0);
    if constexpr (!ALIGN_EPI) { if (wr == 0) PG8_BAR; }
    PG8_BAR;
#undef PG8_SA
#undef PG8_SB
#undef PG8_STAGE
#undef PG8_LDA
#undef PG8_LDB
#undef PG8_MMA
#undef PG8_WAIT_V
#undef PG8_WAIT_L
#undef PG8_BAR
#undef PG8_SCHED
}
}

constexpr int NWAVES = 8, NTHREADS = 512;
constexpr int RING_BYTES = 131072, LDS_BYTES = 147456;
constexpr size_t MiB = 1u << 20;
constexpr size_t SZ_WIN = (size_t)DIN * DM * 2, SZ_WOUT = (size_t)DM * DM * 2, SZ_WUP = (size_t)DFF * DM * 2, SZ_WDN = (size_t)DM * DFF * 2, SZ_SGUW = (size_t)8 * 128 * 128 * 2;
constexpr size_t WS_WIN = 0;
constexpr size_t WS_WOUT = WS_WIN + DEPTH * SZ_WIN;
constexpr size_t WS_WUP = WS_WOUT + DEPTH * SZ_WOUT;
constexpr size_t WS_WDN = WS_WUP + DEPTH * SZ_WUP;
constexpr size_t WS_SGUW = WS_WDN + DEPTH * SZ_WDN;
constexpr size_t WS_RSA = WS_SGUW + DEPTH * SZ_SGUW;
constexpr size_t WS_RSB = WS_RSA + (size_t)DEPTH * M * 4;
constexpr size_t WS_AST = WS_RSB + (size_t)DEPTH * M * 4;
constexpr size_t WS_XB = WS_AST + (size_t)M * 16;
constexpr size_t WS_R = WS_XB + (size_t)M * DM * 2;
constexpr size_t WS_PROJ = WS_R, WS_MIX = WS_R + (size_t)M * DIN * 2, WS_H = WS_R;
constexpr size_t WS_END = WS_R + (size_t)M * DFF * 2;
static_assert(WS_XB % 256 == 0 && WS_R % 256 == 0 && WS_MIX % 256 == 0, "alignment");

struct Args { const float* in[19]; float* out; unsigned char* ws; int ph_lo, ph_hi; };

__device__ __forceinline__ void p0_transpose_item(const float* W, const float* gain, int K, int N, bf16_t* WT, LAS float* scr, int item, int lane) {
    const int nblk = N / 32, kb = item / nblk, nb = item % nblk, k0 = 64 * kb, n0 = 32 * nb;
#pragma unroll 8
    for (int i = 0; i < 32; ++i) { const int kk = 2 * i + (lane >> 5); float w = W[(size_t)(k0 + kk) * N + n0 + (lane & 31)]; if (gain) w *= gain[k0 + kk]; scr[kk * 33 + (lane & 31)] = w; }
    asm volatile("s_waitcnt lgkmcnt(0)" ::: "memory");
    const int c = lane & 7;
#pragma unroll
    for (int j = 0; j < 4; ++j) { const int n = (lane >> 3) + 8 * j; const LAS float* s = scr + (8 * c) * 33 + n;
        u32x4 o; o.x = cvt_pk_bf16(s[0 * 33], s[1 * 33]); o.y = cvt_pk_bf16(s[2 * 33], s[3 * 33]); o.z = cvt_pk_bf16(s[4 * 33], s[5 * 33]); o.w = cvt_pk_bf16(s[6 * 33], s[7 * 33]);
        *(u32x4*)(WT + (size_t)(n0 + n) * K + k0 + 8 * c) = o; }
    asm volatile("s_waitcnt lgkmcnt(0)" ::: "memory");
}

__device__ __forceinline__ float sigmoidf_(float x) { return 1.0f / (1.0f + __expf(-x)); }

__device__ void naive_attn(const bf16_t* PROJ, bf16_t* MIX, float* AST, const float* gq, const float* gk, const float* sinks, int gw, int NGW, int lane) {
    const float gqk = gq[lane] * gk[lane];
    for (int task = gw; task < M * 4; task += NGW) {
        const int t = task >> 2, kvh = task & 3, s = t & (SEQ - 1), t0 = t - s;
        float sstot = 0.f;
        for (int g = 0; g < 4; ++g) {
            const int h = kvh * 4 + g;
            const float q = bf2f(PROJ[(size_t)t * DIN + C_Q + h * 64 + lane]);
            const float qss = wave_sum(q * q);
            const float qg = q * rsqrtf(qss * (1.0f / 64.0f) + EPS) * gqk;
            float lg[2];
#pragma unroll
            for (int e = 0; e < 2; ++e) {
                const int p = s - 127 + lane + 64 * e; const int pc = p < 0 ? 0 : p;
                const bf16_t* kr = PROJ + (size_t)(t0 + pc) * DIN + C_K + kvh * 64;
                float dot = 0.f, kss = 0.f;
                for (int d = 0; d < 64; ++d) { const float kd = bf2f(kr[d]); const float qd = __shfl(qg, d); dot += qd * kd; kss += kd * kd; }
                const float l = dot * rsqrtf(kss * (1.0f / 64.0f) + EPS) * 0.125f;
                lg[e] = p < 0 ? -1e30f : l;
            }
            const float sk = sinks[h];
            const float mx = fmaxf(wave_max(fmaxf(lg[0], lg[1])), sk);
            float p0 = __expf(lg[0] - mx), p1 = __expf(lg[1] - mx);
            const float den = wave_sum(p0 + p1) + __expf(sk - mx);
            p0 /= den; p1 /= den;
            float o = 0.f;
            for (int jj = 0; jj < 128; ++jj) {
                const int p = s - 127 + jj; const int pc = p < 0 ? 0 : p;
                const float pj = jj < 64 ? __shfl(p0, jj) : __shfl(p1, jj - 64);
                o += pj * bf2f(PROJ[(size_t)(t0 + pc) * DIN + C_V + kvh * 64 + lane]);
            }
            MIX[(size_t)t * DM + X_ATT + h * 64 + lane] = f2bf(o);
            sstot += wave_sum(o * o);
        }
        if (lane == 0) AST[(size_t)t * 4 + kvh] = sstot;
    }
}

__device__ void naive_conv(const bf16_t* PROJ, bf16_t* MIX, const float* cw, const float* cb, const float* lng, const float* lnb, int gw, int NGW, int lane) {
    for (int t = gw; t < M; t += NGW) {
        const int s = t & (SEQ - 1), t0 = t - s;
        float v[8];
#pragma unroll
        for (int e = 0; e < 8; ++e) v[e] = cb[lane + 64 * e];
        for (int j = 0; j < 31; ++j) { const int p = s - 30 + j; if (p < 0) continue;
            const bf16_t* r = PROJ + (size_t)(t0 + p) * DIN;
#pragma unroll
            for (int e = 0; e < 8; ++e) { const int c = lane + 64 * e; const float a = bf2f(r[C_CA + c]), gt = bf2f(r[C_CG + c]); v[e] += cw[j * 512 + c] * (a * sigmoidf_(gt)); } }
        float sm = 0.f;
#pragma unroll
        for (int e = 0; e < 8; ++e) sm += v[e];
        const float mean = wave_sum(sm) * (1.0f / 512.0f); float q = 0.f;
#pragma unroll
        for (int e = 0; e < 8; ++e) { v[e] -= mean; q += v[e] * v[e]; }
        const float rstd = rsqrtf(wave_sum(q) * (1.0f / 512.0f) + EPS); float q2 = 0.f;
#pragma unroll
        for (int e = 0; e < 8; ++e) { const int c = lane + 64 * e; float y = v[e] * rstd * lng[c] + lnb[c]; y = y * sigmoidf_(y); v[e] = y; q2 += y * y; }
        const float r2 = rsqrtf(wave_sum(q2) * (1.0f / 512.0f) + EPS);
#pragma unroll
        for (int e = 0; e < 8; ++e) MIX[(size_t)t * DM + X_CONV + lane + 64 * e] = f2bf(v[e] * r2);
    }
}

__device__ void naive_sgu(const bf16_t* PROJ, bf16_t* MIX, const float* lng, const float* lnb, const float* sw, const float* sb, int gw, int NGW, int lane) {
    for (int t = gw; t < M; t += NGW) {
        const int i = t & 127, tc = t - i;
        float acc[8], g[8], b[8];
#pragma unroll
        for (int e = 0; e < 8; ++e) { acc[e] = 0.f; g[e] = lng[lane + 64 * e]; b[e] = lnb[lane + 64 * e]; }
        for (int j = 0; j <= i; ++j) {
            const bf16_t* r = PROJ + (size_t)(tc + j) * DIN + C_SV; float v[8], sm = 0.f;
#pragma unroll
            for (int e = 0; e < 8; ++e) { v[e] = bf2f(r[lane + 64 * e]); sm += v[e]; }
            const float mean = wave_sum(sm) * (1.0f / 512.0f); float q = 0.f;
#pragma unroll
            for (int e = 0; e < 8; ++e) { v[e] -= mean; q += v[e] * v[e]; }
            const float rstd = rsqrtf(wave_sum(q) * (1.0f / 512.0f) + EPS);
#pragma unroll
            for (int e = 0; e < 8; ++e) acc[e] += sw[((size_t)e * 128 + i) * 128 + j] * (v[e] * rstd * g[e] + b[e]);
        }
        float q2 = 0.f;
#pragma unroll
        for (int e = 0; e < 8; ++e) { const float u = bf2f(PROJ[(size_t)t * DIN + C_SU + lane + 64 * e]); acc[e] = u * (acc[e] + sb[e * 128 + i]); q2 += acc[e] * acc[e]; }
        const float r2 = rsqrtf(wave_sum(q2) * (1.0f / 512.0f) + EPS);
#pragma unroll
        for (int e = 0; e < 8; ++e) MIX[(size_t)t * DM + X_SGU + lane + 64 * e] = f2bf(acc[e] * r2);
    }
}

__global__ void __launch_bounds__(NTHREADS, 2) fwd(Args args) {
    extern __shared__ __attribute__((aligned(16))) unsigned char lds_raw[];
    LAS unsigned char* lds = (LAS unsigned char*)lds_raw;
    const int tid = threadIdx.x, lane = tid & 63, wave = __builtin_amdgcn_readfirstlane(tid >> 6);
    const int G = gridDim.x, bx = blockIdx.x;
    const int gw = bx * NWAVES + wave, NGW = G * NWAVES;
    unsigned char* ws = args.ws;
    bf16_t* XB = (bf16_t*)(ws + WS_XB); bf16_t* PROJ = (bf16_t*)(ws + WS_PROJ); bf16_t* MIX = (bf16_t*)(ws + WS_MIX); bf16_t* HB = (bf16_t*)(ws + WS_H);
    float* RSA = (float*)(ws + WS_RSA); float* RSB = (float*)(ws + WS_RSB); float* AST = (float*)(ws + WS_AST);
    const int lo = args.ph_lo, hi = args.ph_hi;
#if MK_ONE_LAUNCH
    cg::grid_group grid = cg::this_grid();
#define SEAM(k) do { if ((k) + 1 < hi) grid.sync(); } while (0)
#else
#define SEAM(k) do { } while (0)
#endif
#define IN(k) (lo <= (k) && (k) < hi)

    if (IN(0)) {
        LAS float* scr = (LAS float*)(lds + wave * 16384);
        constexpr int I_IN = (DM / 64) * (DIN / 32), I_OUT = (DM / 64) * (DM / 32), I_UP = (DM / 64) * (DFF / 32), I_DN = (DFF / 64) * (DM / 32);
        constexpr int I_L = I_IN + I_OUT + I_UP + I_DN;
        for (int it = gw; it < DEPTH * I_L; it += NGW) {
            const int l = it / I_L; int r = it % I_L;
            if (r < I_IN) { p0_transpose_item(args.in[2] + (size_t)l * DM * DIN, args.in[1] + l * DM, DM, DIN, (bf16_t*)(ws + WS_WIN + l * SZ_WIN), scr, r, lane); continue; } r -= I_IN;
            if (r < I_OUT) { p0_transpose_item(args.in[15] + (size_t)l * DM * DM, args.in[14] + l * DM, DM, DM, (bf16_t*)(ws + WS_WOUT + l * SZ_WOUT), scr, r, lane); continue; } r -= I_OUT;
            if (r < I_UP) { p0_transpose_item(args.in[17] + (size_t)l * DM * DFF, args.in[16] + l * DM, DM, DFF, (bf16_t*)(ws + WS_WUP + l * SZ_WUP), scr, r, lane); continue; } r -= I_UP;
            p0_transpose_item(args.in[18] + (size_t)l * DFF * DM, nullptr, DFF, DM, (bf16_t*)(ws + WS_WDN + l * SZ_WDN), scr, r, lane);
        }
        const float* x = args.in[0];
        for (int m = gw; m < M; m += NGW) {
            const f32x4* xr = (const f32x4*)(x + (size_t)m * DM) + lane; float ss = 0.f;
            u32x2* o8 = (u32x2*)(XB + (size_t)m * DM) + lane;
#pragma unroll
            for (int j = 0; j < 8; ++j) { const f32x4 v = xr[64 * j]; ss += (v[0] * v[0] + v[1] * v[1]) + (v[2] * v[2] + v[3] * v[3]); u32x2 w; w.x = cvt_pk_bf16(v[0], v[1]); w.y = cvt_pk_bf16(v[2], v[3]); o8[64 * j] = w; }
            ss = wave_sum(ss); if (lane == 0) RSA[m] = ss;
        }
        SEAM(0);
    }
    for (int l = 0; l < DEPTH; ++l) {
        const int pb = 1 + 5 * l;
        if (IN(pb)) {
            pg8::Gemm g{XB, (const bf16_t*)(ws + WS_WIN + l * SZ_WIN), M, DIN, DM}; pg8::StaticOrder S; S.init(M, DIN, G, bx);
            pg8::EpiScaleBf16<0> E{PROJ, DIN, RSA + (size_t)l * M, 1.0f / DM};
            pg8::gemm_phase<pg8::EpiScaleBf16<0>, true>(lds, g, S, E);
            SEAM(pb);
        }
        if (IN(pb + 1)) {
            int t_ = threadIdx.x; asm volatile("" : "+v"(t_)); const int lane_ = t_ & 63, gw_ = bx * NWAVES + __builtin_amdgcn_readfirstlane(t_ >> 6);
            naive_attn(PROJ, MIX, AST, args.in[3] + l * 64, args.in[4] + l * 64, args.in[5] + l * 16, gw_, NGW, lane_);
            naive_conv(PROJ, MIX, args.in[6] + l * 31 * 512, args.in[7] + l * 512, args.in[8] + l * 512, args.in[9] + l * 512, gw_, NGW, lane_);
            naive_sgu(PROJ, MIX, args.in[10] + l * 512, args.in[11] + l * 512, args.in[12] + (size_t)l * 8 * 128 * 128, args.in[13] + l * 8 * 128, gw_, NGW, lane_);
            SEAM(pb + 1);
        }
        if (IN(pb + 2)) {
            pg8::Gemm g{MIX, (const bf16_t*)(ws + WS_WOUT + l * SZ_WOUT), M, DM, DM}; pg8::StaticOrder S; S.init(M, DM, G, bx);
            pg8::EpiRes<16> E{l == 0 ? args.in[0] : args.out, args.out, XB, RSB + (size_t)l * M, AST, DM};
            pg8::gemm_phase<pg8::EpiRes<16>, true>(lds, g, S, E);
            SEAM(pb + 2);
        }
        if (IN(pb + 3)) {
            pg8::Gemm g{XB, (const bf16_t*)(ws + WS_WUP + l * SZ_WUP), M, DFF, DM}; pg8::StaticOrder S; S.init(M, DFF, G, bx);
            pg8::EpiScaleBf16<1> E{HB, DFF, RSB + (size_t)l * M, 1.0f / DM};
            pg8::gemm_phase<pg8::EpiScaleBf16<1>, true>(lds, g, S, E);
            SEAM(pb + 3);
        }
        if (IN(pb + 4)) {
            const bool lastl = (l == DEPTH - 1);
            pg8::Gemm g{HB, (const bf16_t*)(ws + WS_WDN + l * SZ_WDN), M, DM, DFF}; pg8::StaticOrder S; S.init(M, DM, G, bx);
            pg8::EpiRes<0> E{args.out, args.out, lastl ? nullptr : XB, lastl ? nullptr : RSA + (size_t)(l + 1) * M, nullptr, DM};
            pg8::gemm_phase<pg8::EpiRes<0>, true>(lds, g, S, E);
            SEAM(pb + 4);
        }
    }
#undef IN
#undef SEAM
}

constexpr int NPHASES = 1 + 5 * DEPTH;

extern "C" void kernel_launch(void* const* d_in, const int* in_sizes, int n_in, void* d_out, int out_size, void* d_ws, size_t ws_size, hipStream_t stream) {
    static int grid = 0;
    if (grid == 0) {
        if (n_in != 19 || in_sizes[0] != M * DM || out_size != M * DM || ws_size < WS_END) {
            fprintf(stderr, "kernel_launch: unexpected shapes (n_in %d, in0 %d, out %d, ws %zu need %zu); nothing launched\n", n_in, n_in > 0 ? in_sizes[0] : -1, out_size, ws_size, (size_t)WS_END); grid = -1; return; }
        int dev = 0, cus = 0, per_cu = 0;
        (void)hipGetDevice(&dev); (void)hipDeviceGetAttribute(&cus, hipDeviceAttributeMultiprocessorCount, dev);
        if (hipFuncSetAttribute((const void*)fwd, hipFuncAttributeMaxDynamicSharedMemorySize, LDS_BYTES) != hipSuccess) { fprintf(stderr, "kernel_launch: hipFuncSetAttribute failed\n"); grid = -1; return; }
        (void)hipOccupancyMaxActiveBlocksPerMultiprocessor(&per_cu, (const void*)fwd, NTHREADS, LDS_BYTES);
        if (per_cu < 1) fprintf(stderr, "kernel_launch: occupancy query says %d blocks per CU\n", per_cu);
        (void)hipGetLastError();
        grid = cus > 0 ? cus : 256;
    }
    if (grid < 0) return;
    (void)hipMemsetAsync((unsigned char*)d_ws + WS_RSA + (size_t)M * 4, 0, (size_t)(2 * DEPTH - 1) * M * 4, stream);
    Args a{};
    for (int i = 0; i < 19; ++i) a.in[i] = (const float*)d_in[i];
    a.out = (float*)d_out; a.ws = (unsigned char*)d_ws;
#if MK_ONE_LAUNCH
    a.ph_lo = 0; a.ph_hi = NPHASES;
    void* kargs[] = {&a};
    hipError_t e = hipLaunchCooperativeKernel((const void*)fwd, dim3(grid), dim3(NTHREADS), kargs, LDS_BYTES, stream);
    if (e != hipSuccess) fprintf(stderr, "cooperative launch failed: %s (grid %d)\n", hipGetErrorString(e), grid);
#else
    for (int p = 0; p < NPHASES; ++p) {
        a.ph_lo = p; a.ph_hi = p + 1;
        hipLaunchKernelGGL(fwd, dim3(grid), dim3(NTHREADS), LDS_BYTES, stream, a);
    }
#endif
}
```

```cpp
#include <hip/hip_runtime.h>
#include <hip/hip_cooperative_groups.h>
#include <cstdio>
#include <cstdint>
namespace cg = cooperative_groups;

#ifndef MK_ONE_LAUNCH
#define MK_ONE_LAUNCH 1
#endif

constexpr int DM = 2048, SEQ = 2048, NB = 8, M = NB * SEQ, DIN = 3584, DFF = 8192, DEPTH = 2;
constexpr int C_Q = 0, C_K = 1024, C_V = 1280, C_CA = 1536, C_CG = 2048, C_SU = 2560, C_SV = 3072;
constexpr int X_ATT = 0, X_CONV = 1024, X_SGU = 1536;
constexpr float EPS = 1e-6f;

#define LAS __attribute__((address_space(3)))
typedef unsigned short bf16_t;
typedef short bf16x8 __attribute__((ext_vector_type(8)));
typedef float f32x4 __attribute__((ext_vector_type(4)));
typedef unsigned u32x4 __attribute__((ext_vector_type(4)));
typedef unsigned u32x2 __attribute__((ext_vector_type(2)));

__device__ __forceinline__ unsigned cvt_pk_bf16(float lo, float hi) { unsigned r; asm volatile("v_cvt_pk_bf16_f32 %0, %1, %2" : "=v"(r) : "v"(lo), "v"(hi)); return r; }
__device__ __forceinline__ float bf2f(bf16_t b) { return __uint_as_float(((unsigned)b) << 16); }
__device__ __forceinline__ bf16_t f2bf(float f) { return (bf16_t)(cvt_pk_bf16(f, 0.f) & 0xffffu); }
__device__ __forceinline__ int lane_id() { int x; asm volatile("v_mbcnt_lo_u32_b32 %0, -1, 0\n\tv_mbcnt_hi_u32_b32 %0, -1, %0" : "=v"(x)); return x; }
__device__ __forceinline__ float shx(float v, int o, int lane) { return __int_as_float(__builtin_amdgcn_ds_bpermute((lane ^ o) << 2, __float_as_int(v))); }
__device__ __forceinline__ float shl(float v, int src) { return __int_as_float(__builtin_amdgcn_ds_bpermute(src << 2, __float_as_int(v))); }
__device__ __forceinline__ float wave_sum(float v, int lane) {
#pragma unroll
    for (int o = 1; o < 64; o <<= 1) v += shx(v, o, lane);
    return v;
}
__device__ __forceinline__ float wave_max(float v, int lane) {
#pragma unroll
    for (int o = 1; o < 64; o <<= 1) v = fmaxf(v, shx(v, o, lane));
    return v;
}

__device__ __forceinline__ size_t blk_off(int row, int col) { return (((size_t)(row >> 8) * (DM / 64) + (col >> 6)) * 256 + (row & 255)) * 64 + (col & 63); }

namespace pg8 {
constexpr int BM = 256, BK = 64, HALF = 128, HTB = HALF * BK * 2, STAGE_BYTES = 8 * HTB, NXCD = 8, WGM = 8;
__host__ __device__ __forceinline__ int lds_byte(int r, int c) { const int st = (r >> 4) * 2 + (c >> 5), rr = r & 15, cc = c & 31, ob = rr * 64 + cc * 2; return st * 1024 + (ob ^ (((ob >> 9) & 1) << 5)); }
__host__ __device__ __forceinline__ void stage_rc(int b, int& R, int& C) { const int st = b / 1024, sb = b % 1024, swz = sb ^ (((sb >> 9) & 1) << 5); R = (st >> 1) * 16 + swz / 64; C = (st & 1) * 32 + (swz % 64) / 2; }
__host__ __device__ __forceinline__ int perm32(int rho) { const int n = rho >> 4, i = rho & 15; return 8 * (i >> 2) + 4 * n + (i & 3); }

struct Unit { int pm, pn; };
struct Gemm { const bf16_t* A; const bf16_t* Bt; int M, N, K; };

struct StaticOrder {
    int nM, nN, nwg, G, c, pnfast;
    __host__ __device__ void init(int M_, int N_, int G_, int c_, int pnfast_ = 0) { nM = M_ / BM; nN = N_ / BM; nwg = nM * nN; G = G_; c = c_; pnfast = pnfast_; }
    __host__ __device__ bool next(int i, Unit& u) const {
        const long L = (long)i * G + c; if (L >= nwg) return false;
        int wgid = (int)L; { const int q = nwg / NXCD, r = nwg % NXCD, xcd = wgid % NXCD, off = wgid / NXCD; wgid = (xcd < r ? xcd * (q + 1) : r * (q + 1) + (xcd - r) * q) + off; }
        const int nig = WGM * nN, gid = wgid / nig, fm = gid * WGM, gsz = (nM - fm) < WGM ? (nM - fm) : WGM;
        if (pnfast) { u.pn = (wgid % nig) % nN; u.pm = fm + (wgid % nig) / nN; } else { u.pm = fm + ((wgid % nig) % gsz); u.pn = (wgid % nig) / gsz; }
        return true;
    }
};

template <int ACT, bool OBLK = false> struct EpiScaleBf16 {
    static constexpr bool PERM = true; static constexpr int MID_T = 0;
    bf16_t* O; int ldc; const float* rowss; float inv_n;
    __device__ __forceinline__ void mid(f32x4 (&)[2][2][4][2], const Unit&, int, int) const {}
    __device__ __forceinline__ void prefetch(float (&pre)[8], const Unit& u, int wr, int fr) const {
        const float* p = rowss + u.pm * BM + wr * 64 + fr;
#pragma unroll
        for (int ai = 0; ai < 2; ++ai)
#pragma unroll
            for (int m = 0; m < 4; ++m) pre[ai * 4 + m] = p[ai * HALF + m * 16];
    }
    __device__ __forceinline__ void operator()(const f32x4 (&acc)[2][2][4][2], const float (&pre)[8], const Unit& u, int wr, int wc, int fr, int fq) const {
        const int row0 = u.pm * BM + wr * 64 + fr; const int col0 = u.pn * BM + wc * 32 + 8 * fq;
#pragma unroll
        for (int ai = 0; ai < 2; ++ai)
#pragma unroll
            for (int m = 0; m < 4; ++m) { const int row = row0 + ai * HALF + m * 16; const float rs = rsqrtf(pre[ai * 4 + m] * inv_n + EPS);
                bf16_t* rowp = OBLK ? O + (((size_t)u.pm * (ldc >> 6) + (col0 >> 6)) * 256 + (row & 255)) * 64 + (col0 & 63) : O + (size_t)row * ldc + col0;
#pragma unroll
                for (int bj = 0; bj < 2; ++bj) { f32x4 v0 = acc[ai][bj][m][0] * rs, v1 = acc[ai][bj][m][1] * rs;
                    if (ACT == 1) {
#pragma unroll
                        for (int e = 0; e < 4; ++e) { float a = fmaxf(v0[e], 0.f), b = fmaxf(v1[e], 0.f); v0[e] = a * a; v1[e] = b * b; } }
                    u32x4 w; w.x = cvt_pk_bf16(v0[0], v0[1]); w.y = cvt_pk_bf16(v0[2], v0[3]); w.z = cvt_pk_bf16(v1[0], v1[1]); w.w = cvt_pk_bf16(v1[2], v1[3]);
                    *(u32x4*)(rowp + (OBLK ? bj * (HALF / 64) * 256 * 64 : bj * HALF)) = w; } }
    }
};
template <int MIDT, bool FINAL> struct EpiRes {
    static constexpr bool PERM = true; static constexpr int MID_T = MIDT;
    bf16_t* xb; float* outf; float* rowss_out; const float* astat; int ldc;
    __device__ __forceinline__ void mid(f32x4 (&acc)[2][2][4][2], const Unit& u, int wr, int fr) const {
        const int row0 = u.pm * BM + wr * 64 + fr;
#pragma unroll
        for (int ai = 0; ai < 2; ++ai)
#pragma unroll
            for (int m = 0; m < 4; ++m) { const int row = row0 + ai * HALF + m * 16; const f32x4 s = *(const f32x4*)(astat + (size_t)row * 4);
                const float r1 = rsqrtf(((s[0] + s[1]) + (s[2] + s[3])) * (1.0f / 1024.0f) + EPS);
#pragma unroll
                for (int bj = 0; bj < 2; ++bj)
#pragma unroll
                    for (int n = 0; n < 2; ++n) acc[ai][bj][m][n] = acc[ai][bj][m][n] * r1;
                asm volatile("" ::: "memory"); }
    }
    __device__ __forceinline__ void prefetch(float (&)[8], const Unit&, int, int) const {}
    __device__ __forceinline__ void operator()(const f32x4 (&acc)[2][2][4][2], const float (&)[8], const Unit& u, int wr, int wc, int fr, int fq) const {
        const int row0 = u.pm * BM + wr * 64 + fr; const int col0 = u.pn * BM + wc * 32 + 8 * fq, lane = fr + 16 * fq;
        u32x4 bv[2][4][2];
#pragma unroll
        for (int ai = 0; ai < 2; ++ai)
#pragma unroll
            for (int m = 0; m < 4; ++m) { const bf16_t* rp = xb + blk_off(row0 + ai * HALF + m * 16, col0);
#pragma unroll
                for (int bj = 0; bj < 2; ++bj) bv[ai][m][bj] = *(const u32x4*)(rp + bj * (2 * 256 * 64)); }
#pragma unroll
        for (int ai = 0; ai < 2; ++ai)
#pragma unroll
            for (int m = 0; m < 4; ++m) { const int row = row0 + ai * HALF + m * 16; const size_t off = (size_t)row * ldc + col0; float ss = 0.f;
#pragma unroll
                for (int bj = 0; bj < 2; ++bj) { const u32x4 b = bv[ai][m][bj]; f32x4 o0, o1;
                    o0[0] = __uint_as_float(b.x << 16); o0[1] = __uint_as_float(b.x & 0xffff0000u); o0[2] = __uint_as_float(b.y << 16); o0[3] = __uint_as_float(b.y & 0xffff0000u);
                    o1[0] = __uint_as_float(b.z << 16); o1[1] = __uint_as_float(b.z & 0xffff0000u); o1[2] = __uint_as_float(b.w << 16); o1[3] = __uint_as_float(b.w & 0xffff0000u);
                    o0 = o0 + acc[ai][bj][m][0]; o1 = o1 + acc[ai][bj][m][1];
                    if (FINAL) { *(f32x4*)(outf + off + bj * HALF) = o0; *(f32x4*)(outf + off + bj * HALF + 4) = o1; }
                    else { u32x4 w; w.x = cvt_pk_bf16(o0[0], o0[1]); w.y = cvt_pk_bf16(o0[2], o0[3]); w.z = cvt_pk_bf16(o1[0], o1[1]); w.w = cvt_pk_bf16(o1[2], o1[3]);
                        *(u32x4*)(xb + blk_off(row, col0) + bj * (2 * 256 * 64)) = w; }
                    ss += ((o0[0] * o0[0] + o0[1] * o0[1]) + (o0[2] * o0[2] + o0[3] * o0[3])) + ((o1[0] * o1[0] + o1[1] * o1[1]) + (o1[2] * o1[2] + o1[3] * o1[3])); }
                if (!FINAL) { if (rowss_out) { ss += shx(ss, 16, lane); ss += shx(ss, 32, lane); if (fq == 0) atomicAdd(rowss_out + row, ss); } } }
    }
};

template <class Epi, bool ALIGN_EPI, bool ABLK = false, bool BBLK = false>
__device__ __forceinline__ void gemm_phase(LAS unsigned char* lds, const Gemm g, const StaticOrder& S, const Epi& E, int wave_s) {
    int tid = wave_s * 64 + lane_id(); asm volatile("" : "+v"(tid));
    const int wid = __builtin_amdgcn_readfirstlane(tid >> 6), lane = tid & 63, wr = wid >> 2, wc = wid & 3, fr = lane & 15, fq = lane >> 4;
    const int K = g.K, nt = K / BK;
    unsigned voffA, voffB;
    const int pitchA = ABLK ? 64 : K, pitchB = BBLK ? 64 : K;
    { int R, C; stage_rc(tid * 16, R, C); const int Rb = Epi::PERM ? ((R & ~31) + perm32(R & 31)) : R; voffA = (unsigned)(R * pitchA + C) * 2u; voffB = (unsigned)(Rb * pitchB + C) * 2u; }
    const size_t r64A = (size_t)64 * pitchA * 2, r64B = (size_t)64 * pitchB * 2;
    const size_t kstepA = ABLK ? (size_t)(BM * BK * 2) : (size_t)(BK * 2), kstepB = BBLK ? (size_t)(BM * BK * 2) : (size_t)(BK * 2);
    const size_t hstepA = (size_t)HALF * pitchA * 2, hstepB = (size_t)HALF * pitchB * 2;
    const size_t tstep = (size_t)BM * K * 2;
    const unsigned ldsw = (unsigned)wid * 1024u;
    const int aoff = lds_byte(wr * 64 + fr, fq * 8), boff = lds_byte(wc * 32 + fr, fq * 8);
#define PG8_SA(b, h) (((b) * 2 + (h)) * HTB)
#define PG8_SB(b, h) ((4 + (b) * 2 + (h)) * HTB)
#define PG8_STAGE(bufoff, gbase, voff, r64) do { _Pragma("unroll") for (int _i = 0; _i < 2; ++_i) \
        __builtin_amdgcn_global_load_lds((const unsigned*)((const char*)(gbase) + _i * r64 + (voff)), (LAS unsigned*)(lds + (bufoff) + ldsw + _i * 8192), 16, 0, 0); } while (0)
#define PG8_LDA(dst, b, h) do { _Pragma("unroll") for (int m = 0; m < 4; ++m) _Pragma("unroll") for (int k = 0; k < 2; ++k) dst[m][k] = *(const LAS bf16x8*)(lds + PG8_SA(b, h) + aoff + m * 2048 + k * 1024); } while (0)
#define PG8_LDB(dst, b, h) do { _Pragma("unroll") for (int n = 0; n < 2; ++n) _Pragma("unroll") for (int k = 0; k < 2; ++k) dst[n][k] = *(const LAS bf16x8*)(lds + PG8_SB(b, h) + boff + n * 2048 + k * 1024); } while (0)
#define PG8_MMA(ai, bj, At, Bt) do { __builtin_amdgcn_s_setprio(1); _Pragma("unroll") for (int m = 0; m < 4; ++m) _Pragma("unroll") for (int n = 0; n < 2; ++n) _Pragma("unroll") for (int k = 0; k < 2; ++k) \
        acc[ai][bj][m][n] = __builtin_amdgcn_mfma_f32_16x16x32_bf16(Bt[n][k], At[m][k], acc[ai][bj][m][n], 0, 0, 0); __builtin_amdgcn_s_setprio(0); } while (0)
#define PG8_WAIT_V(n) asm volatile("s_waitcnt vmcnt(" #n ")" ::: "memory")
#define PG8_WAIT_L(n) asm volatile("s_waitcnt lgkmcnt(" #n ")" ::: "memory")
#define PG8_BAR __builtin_amdgcn_s_barrier()
#define PG8_SCHED __builtin_amdgcn_sched_barrier(0)
    Unit cur, nxt; int ui = 0;
    if (!S.next(0, cur)) return;
    f32x4 acc[2][2][4][2];
#pragma unroll
    for (int a = 0; a < 2; ++a)
#pragma unroll
        for (int b = 0; b < 2; ++b)
#pragma unroll
            for (int m = 0; m < 4; ++m)
#pragma unroll
                for (int n = 0; n < 2; ++n) acc[a][b][m][n] = (f32x4){0.f, 0.f, 0.f, 0.f};
    bf16x8 At[4][2], B0[2][2], B1[2][2];
    float pre[8];
#pragma unroll
    for (int k = 0; k < 8; ++k) pre[k] = 0.f;
    const char* cA = (const char*)g.A + (size_t)cur.pm * tstep; const char* cB = (const char*)g.Bt + (size_t)cur.pn * tstep;
    PG8_STAGE(PG8_SB(0, 0), cB, voffB, r64B); PG8_STAGE(PG8_SB(0, 1), cB + hstepB, voffB, r64B); PG8_STAGE(PG8_SA(0, 0), cA, voffA, r64A); PG8_STAGE(PG8_SA(0, 1), cA + hstepA, voffA, r64A);
    PG8_STAGE(PG8_SB(1, 0), cB + kstepB, voffB, r64B); PG8_STAGE(PG8_SA(1, 0), cA + kstepA, voffA, r64A); PG8_STAGE(PG8_SB(1, 1), cB + hstepB + kstepB, voffB, r64B);
    if (wr == 1) PG8_BAR;
    PG8_WAIT_V(8); PG8_BAR;
    PG8_WAIT_V(6); PG8_BAR;
    for (;;) {
        const bool has_next = S.next(ui + 1, nxt);
        const char* nA = has_next ? (const char*)g.A + (size_t)nxt.pm * tstep : cA; const char* nB = has_next ? (const char*)g.Bt + (size_t)nxt.pn * tstep : cB;
        for (int t = 0; t < nt; t += 2) {
            if constexpr (Epi::MID_T > 0) { if (t == Epi::MID_T) E.mid(acc, cur, wr, fr); }
            const bool last = (t == nt - 2);
            if (last) E.prefetch(pre, cur, wr, fr);
            const char* a1 = cA + (size_t)(t + 1) * kstepA;
            const char* a2 = last ? nA : cA + (size_t)(t + 2) * kstepA; const char* b2 = last ? nB : cB + (size_t)(t + 2) * kstepB;
            const char* a3 = a2 + kstepA; const char* b3 = b2 + kstepB;
            PG8_LDB(B0, 0, 0); PG8_LDB(B1, 0, 1); PG8_SCHED; PG8_LDA(At, 0, 0); PG8_STAGE(PG8_SA(1, 1), a1 + hstepA, voffA, r64A);
            PG8_WAIT_V(8); PG8_WAIT_L(0); PG8_BAR; PG8_MMA(0, 0, At, B0); PG8_MMA(0, 1, At, B1); PG8_BAR; PG8_SCHED;
            PG8_LDA(At, 0, 1); PG8_STAGE(PG8_SB(0, 0), b2, voffB, r64B); PG8_STAGE(PG8_SB(0, 1), b2 + hstepB, voffB, r64B); PG8_STAGE(PG8_SA(0, 0), a2, voffA, r64A);
            PG8_WAIT_V(8); PG8_WAIT_L(0); PG8_BAR; PG8_MMA(1, 0, At, B0); PG8_MMA(1, 1, At, B1); PG8_BAR; PG8_SCHED;
            PG8_LDB(B0, 1, 0); PG8_LDB(B1, 1, 1); PG8_SCHED; PG8_LDA(At, 1, 0); PG8_STAGE(PG8_SA(0, 1), a2 + hstepA, voffA, r64A);
            PG8_WAIT_V(8); PG8_WAIT_L(0); PG8_BAR; PG8_MMA(0, 0, At, B0); PG8_MMA(0, 1, At, B1); PG8_BAR; PG8_SCHED;
            PG8_LDA(At, 1, 1); PG8_STAGE(PG8_SB(1, 0), b3, voffB, r64B); PG8_STAGE(PG8_SB(1, 1), b3 + hstepB, voffB, r64B); PG8_STAGE(PG8_SA(1, 0), a3, voffA, r64A);
            PG8_WAIT_V(8); PG8_WAIT_L(0); PG8_BAR; PG8_MMA(1, 0, At, B0); PG8_MMA(1, 1, At, B1); PG8_BAR; PG8_SCHED;
        }
        if constexpr (ALIGN_EPI) { if (wr == 0) PG8_BAR; }
        E(acc, pre, cur, wr, wc, fr, fq);
        if (!has_next) break;
#pragma unroll
        for (int a = 0; a < 2; ++a)
#pragma unroll
            for (int b = 0; b < 2; ++b)
#pragma unroll
                for (int m = 0; m < 4; ++m)
#pragma unroll
                    for (int n = 0; n < 2; ++n) acc[a][b][m][n] = (f32x4){0.f, 0.f, 0.f, 0.f};
        cur = nxt; cA = nA; cB = nB; ++ui;
        if constexpr (ALIGN_EPI) { if (wr == 1) PG8_BAR; }
    }
    PG8_WAIT_V(0);
    if constexpr (!ALIGN_EPI) { if (wr == 0) PG8_BAR; }
    PG8_BAR;
#undef PG8_SA
#undef PG8_SB
#undef PG8_STAGE
#undef PG8_LDA
#undef PG8_LDB
#undef PG8_MMA
#undef PG8_WAIT_V
#undef PG8_WAIT_L
#undef PG8_BAR
#undef PG8_SCHED
}
}

constexpr int NWAVES = 8, NTHREADS = 512;
constexpr int RING_BYTES = 131072, LDS_BYTES = 147456;
constexpr size_t MiB = 1u << 20;
constexpr size_t SZ_WIN = (size_t)DIN * DM * 2, SZ_WOUT = (size_t)DM * DM * 2, SZ_WUP = (size_t)DFF * DM * 2, SZ_WDN = (size_t)DM * DFF * 2, SZ_SGUW = (size_t)8 * 128 * 128 * 2;
constexpr size_t WS_WIN = 0;
constexpr size_t WS_WOUT = WS_WIN + DEPTH * SZ_WIN;
constexpr size_t WS_WUP = WS_WOUT + DEPTH * SZ_WOUT;
constexpr size_t WS_WDN = WS_WUP + DEPTH * SZ_WUP;
constexpr size_t WS_SGUW = WS_WDN + DEPTH * SZ_WDN;
constexpr size_t WS_BAR = WS_SGUW + DEPTH * SZ_SGUW;
constexpr size_t WS_RSA = WS_BAR + 16384;
constexpr size_t WS_RSB = WS_RSA + (size_t)DEPTH * M * 4;
constexpr size_t WS_AST = WS_RSB + (size_t)DEPTH * M * 4;
constexpr size_t WS_XB = WS_AST + (size_t)M * 16;
constexpr size_t WS_R = WS_XB + (size_t)M * DM * 2;
constexpr size_t WS_PROJ = WS_R, WS_MIX = WS_R + (size_t)M * DIN * 2, WS_H = WS_R;
constexpr size_t WS_END = WS_R + (size_t)M * DFF * 2;
static_assert(WS_XB % 256 == 0 && WS_R % 256 == 0 && WS_MIX % 256 == 0, "alignment");

struct Args { const float* in[19]; float* out; unsigned char* ws; int ph_lo, ph_hi; };

__device__ __forceinline__ void p0_transpose_item(const float* W, const float* gain, int K, int N, bf16_t* WT, LAS float* scr, int item, int lane) {
    const int nblk = N / 64, kb = item / nblk, nb = item % nblk, k0 = 64 * kb, n0 = 64 * nb;
    const int kq = lane >> 4, col = 4 * (lane & 15);
    const float* src = W + (size_t)(k0 + kq) * N + n0 + col;
    f32x4 v[16];
#pragma unroll
    for (int i = 0; i < 16; ++i) v[i] = *(const f32x4*)(src + (size_t)(4 * i) * N);
    if (gain) {
#pragma unroll
        for (int i = 0; i < 16; ++i) v[i] = v[i] * gain[k0 + 4 * i + kq];
    }
#pragma unroll
    for (int i = 0; i < 16; ++i) { LAS float* d = scr + (4 * i + kq) * 65 + col; d[0] = v[i][0]; d[1] = v[i][1]; d[2] = v[i][2]; d[3] = v[i][3]; }
    asm volatile("s_waitcnt lgkmcnt(0)" ::: "memory");
    const int c = lane & 7;
#pragma unroll
    for (int j = 0; j < 8; ++j) { const int n = (lane >> 3) + 8 * j; const LAS float* s = scr + (8 * c) * 65 + n;
        u32x4 o; o.x = cvt_pk_bf16(s[0 * 65], s[1 * 65]); o.y = cvt_pk_bf16(s[2 * 65], s[3 * 65]); o.z = cvt_pk_bf16(s[4 * 65], s[5 * 65]); o.w = cvt_pk_bf16(s[6 * 65], s[7 * 65]);
        const int na = n0 + n; *(u32x4*)(WT + ((size_t)((na >> 8) * (K >> 6) + kb) * 256 + (na & 255)) * 64 + 8 * c) = o; }
    asm volatile("s_waitcnt lgkmcnt(0)" ::: "memory");
}

typedef float f32x16 __attribute__((ext_vector_type(16)));
__device__ __forceinline__ float sigm(float x) { return __builtin_amdgcn_rcpf(1.0f + __expf(-x)); }

typedef float f32x2 __attribute__((ext_vector_type(2)));
__device__ __forceinline__ void conv_unit(LAS unsigned char* lds, int unit, const bf16_t* PROJ, bf16_t* MIX, const float* cw, const float* cb, const float* lng, const float* lnb, int tid_in) {
    int tid = tid_in; asm volatile("" : "+v"(tid));
    const int lane = tid & 63, wave = tid >> 6;
    const int tb = unit * 64, s0 = tb & (SEQ - 1), blk = wave >> 2, c0 = 128 * (wave & 3) + 2 * lane;
    LAS float* cv = (LAS float*)lds;
    __syncthreads();
    {
        f32x2 w[31];
#pragma unroll
        for (int j = 0; j < 31; ++j) w[j] = *(const f32x2*)(cw + j * 512 + c0);
        const f32x2 bias = *(const f32x2*)(cb + c0);
        f32x2 acc[32];
#pragma unroll
        for (int o = 0; o < 32; ++o) acc[o] = bias;
        const int p0 = s0 + blk * 32 - 30;
        const bf16_t* rp = PROJ + ((ptrdiff_t)(tb + blk * 32 - 30) * DIN + c0);
        unsigned ra[2][16], rg[2][16];
#pragma unroll
        for (int k = 0; k < 16; ++k) { ra[0][k] = *(const unsigned*)(rp + (ptrdiff_t)k * DIN + C_CA); rg[0][k] = *(const unsigned*)(rp + (ptrdiff_t)k * DIN + C_CG); }
#pragma unroll
        for (int gi = 0; gi < 4; ++gi) {
            rp += 16 * DIN; asm volatile("" : "+v"(rp));
            if (gi < 3) {
#pragma unroll
                for (int k = 0; k < 16; ++k) if (gi * 16 + 16 + k < 62) { ra[(gi + 1) & 1][k] = *(const unsigned*)(rp + (ptrdiff_t)k * DIN + C_CA); rg[(gi + 1) & 1][k] = *(const unsigned*)(rp + (ptrdiff_t)k * DIN + C_CG); }
            }
#pragma unroll
            for (int k = 0; k < 16; ++k) { const int ii = gi * 16 + k; if (ii < 62) {
                const unsigned a = ra[gi & 1][k], gt = rg[gi & 1][k];
                f32x2 hv; hv.x = __uint_as_float(a << 16) * sigm(__uint_as_float(gt << 16)); hv.y = __uint_as_float(a & 0xffff0000u) * sigm(__uint_as_float(gt & 0xffff0000u));
                if ((p0 + ii) < 0) hv = (f32x2){0.f, 0.f};
#pragma unroll
                for (int o = 0; o < 32; ++o) { const int j = ii - o; if (j >= 0 && j <= 30) acc[o] += w[j] * hv; } } }
        }
        LAS float* cvb = cv + blk * 32 * 512 + c0; asm volatile("" : "+v"(cvb));
#pragma unroll
        for (int o = 0; o < 32; ++o) *(LAS f32x2*)(cvb + o * 512) = acc[o];
    }
    __syncthreads();
    {
        const f32x4 g0 = *(const f32x4*)(lng + 4 * lane), g1 = *(const f32x4*)(lng + 256 + 4 * lane), b0 = *(const f32x4*)(lnb + 4 * lane), b1 = *(const f32x4*)(lnb + 256 + 4 * lane);
        f32x4 v0[8], v1[8]; float red[8];
        const LAS float* cvr = cv + wave * 8 * 512 + 4 * lane;
#pragma unroll
        for (int r = 0; r < 8; ++r) { v0[r] = *(const LAS f32x4*)(cvr + r * 512); v1[r] = *(const LAS f32x4*)(cvr + r * 512 + 256);
            red[r] = ((v0[r][0] + v0[r][1]) + (v0[r][2] + v0[r][3])) + ((v1[r][0] + v1[r][1]) + (v1[r][2] + v1[r][3])); }
#pragma unroll
        for (int o = 1; o < 64; o <<= 1)
#pragma unroll
            for (int r = 0; r < 8; ++r) red[r] += shx(red[r], o, lane);
#pragma unroll
        for (int r = 0; r < 8; ++r) { const float mean = red[r] * (1.0f / 512.0f); v0[r] = v0[r] - mean; v1[r] = v1[r] - mean;
            red[r] = ((v0[r][0] * v0[r][0] + v0[r][1] * v0[r][1]) + (v0[r][2] * v0[r][2] + v0[r][3] * v0[r][3])) + ((v1[r][0] * v1[r][0] + v1[r][1] * v1[r][1]) + (v1[r][2] * v1[r][2] + v1[r][3] * v1[r][3])); }
#pragma unroll
        for (int o = 1; o < 64; o <<= 1)
#pragma unroll
            for (int r = 0; r < 8; ++r) red[r] += shx(red[r], o, lane);
#pragma unroll
        for (int r = 0; r < 8; ++r) { const float rstd = rsqrtf(red[r] * (1.0f / 512.0f) + EPS); v0[r] = v0[r] * rstd * g0 + b0; v1[r] = v1[r] * rstd * g1 + b1; float q2 = 0.f;
#pragma unroll
            for (int e = 0; e < 4; ++e) { v0[r][e] = v0[r][e] * sigm(v0[r][e]); v1[r][e] = v1[r][e] * sigm(v1[r][e]); q2 += v0[r][e] * v0[r][e] + v1[r][e] * v1[r][e]; }
            red[r] = q2; }
#pragma unroll
        for (int o = 1; o < 64; o <<= 1)
#pragma unroll
            for (int r = 0; r < 8; ++r) red[r] += shx(red[r], o, lane);
        bf16_t* orow = MIX + blk_off(tb + wave * 8, X_CONV + 4 * lane);
#pragma unroll
        for (int r = 0; r < 8; ++r) { const float r2 = rsqrtf(red[r] * (1.0f / 512.0f) + EPS); const f32x4 a = v0[r] * r2, c = v1[r] * r2;
            u32x2 o0, o1; o0.x = cvt_pk_bf16(a[0], a[1]); o0.y = cvt_pk_bf16(a[2], a[3]); o1.x = cvt_pk_bf16(c[0], c[1]); o1.y = cvt_pk_bf16(c[2], c[3]);
            *(u32x2*)(orow + r * 64) = o0; *(u32x2*)(orow + r * 64 + 4 * 256 * 64) = o1; }
    }
}

constexpr int SG_P = 136;
__device__ __forceinline__ void sgu_unit(LAS unsigned char* lds, int unit, const bf16_t* PROJ, bf16_t* MIX, const bf16_t* SW, const float* lng, const float* lnb, const float* sb, int tid_in) {
    int tid = tid_in; asm volatile("" : "+v"(tid));
    const int lane = tid & 63, wave = __builtin_amdgcn_readfirstlane(tid >> 6);
    const int tc = unit * 128;
    LAS bf16_t* Vt = (LAS bf16_t*)lds;
    LAS float* st = (LAS float*)(lds + 512 * SG_P * 2);
    __syncthreads();
    u32x4 raws[16];
#pragma unroll
    for (int rr = 0; rr < 16; ++rr) raws[rr] = *(const u32x4*)(PROJ + (size_t)(tc + wave * 16 + rr) * DIN + C_SV + 8 * lane);
#pragma unroll
    for (int rr = 0; rr < 16; ++rr) {
        const int j = wave * 16 + rr;
        const u32x4 raw = raws[rr];
        float v[8];
#pragma unroll
        for (int e = 0; e < 4; ++e) { v[2 * e] = __uint_as_float(raw[e] << 16); v[2 * e + 1] = __uint_as_float(raw[e] & 0xffff0000u); }
        float sm = 0.f;
#pragma unroll
        for (int e = 0; e < 8; ++e) sm += v[e];
        const float mean = wave_sum(sm, lane) * (1.0f / 512.0f); float q = 0.f;
#pragma unroll
        for (int e = 0; e < 8; ++e) { const float d = v[e] - mean; q += d * d; }
        const float rstd = rsqrtf(wave_sum(q, lane) * (1.0f / 512.0f) + EPS);
        if (lane == 0) { st[2 * j] = mean; st[2 * j + 1] = rstd; }
    }
    __syncthreads();
    {
        const int c = tid; const float g = lng[c], b = lnb[c];
        const bf16_t* src = PROJ + (size_t)tc * DIN + C_SV + c;
#pragma unroll 1
        for (int jb = 0; jb < 4; ++jb) {
            bf16_t rv[32];
#pragma unroll
            for (int e = 0; e < 32; ++e) rv[e] = src[(size_t)(32 * jb + e) * DIN];
#pragma unroll
            for (int jg = 0; jg < 4; ++jg) {
                float vn[8];
#pragma unroll
                for (int e = 0; e < 8; ++e) { const int j = 32 * jb + 8 * jg + e; vn[e] = (bf2f(rv[8 * jg + e]) - st[2 * j]) * st[2 * j + 1] * g + b; }
                u32x4 o; o.x = cvt_pk_bf16(vn[0], vn[1]); o.y = cvt_pk_bf16(vn[2], vn[3]); o.z = cvt_pk_bf16(vn[4], vn[5]); o.w = cvt_pk_bf16(vn[6], vn[7]);
                *(LAS u32x4*)(Vt + c * SG_P + 32 * jb + 8 * jg) = o;
            }
        }
    }
    __syncthreads();
    const int fr = lane & 15, fq = lane >> 4, irow = 16 * wave + fr, nks = (wave >> 1) + 1;
    f32x4 outv[8][4]; float ssq = 0.f;
    bf16x8 wa[2][4]; u32x2 ub[2][4]; float bs[2];
#define SGU_LOAD(buf, hh_) do { int hr = (hh_); asm volatile("" : "+s"(hr)); const bf16_t* swh = SW + ((size_t)(hr * 128 + irow) * 128 + 8 * fq); \
        _Pragma("unroll") for (int ks = 0; ks < 4; ++ks) wa[buf][ks] = *(const bf16x8*)(swh + 32 * ks); \
        const bf16_t* up = PROJ + (size_t)(tc + irow) * DIN + C_SU + hr * 64 + 4 * fq; \
        _Pragma("unroll") for (int nt = 0; nt < 4; ++nt) ub[buf][nt] = *(const u32x2*)(up + 16 * nt); \
        bs[buf] = sb[hr * 128 + irow]; } while (0)
    SGU_LOAD(0, 0);
#pragma unroll
    for (int h = 0; h < 8; ++h) {
        if (h < 7) SGU_LOAD((h + 1) & 1, h + 1);
        int hr = h; asm volatile("" : "+s"(hr));
        f32x4 acc[4];
#pragma unroll
        for (int nt = 0; nt < 4; ++nt) acc[nt] = (f32x4){0.f, 0.f, 0.f, 0.f};
        const LAS bf16_t* vth = Vt + (hr * 64 + fr) * SG_P + 8 * fq;
#pragma unroll
        for (int ks = 0; ks < 4; ++ks) if (ks < nks) {
#pragma unroll
            for (int nt = 0; nt < 4; ++nt) { const bf16x8 bf = *(const LAS bf16x8*)(vth + 16 * nt * SG_P + 32 * ks);
                acc[nt] = __builtin_amdgcn_mfma_f32_16x16x32_bf16(bf, wa[h & 1][ks], acc[nt], 0, 0, 0); }
        }
        const float bias = bs[h & 1];
#pragma unroll
        for (int nt = 0; nt < 4; ++nt) {
            const u32x2 ur = ub[h & 1][nt];
            f32x4 u; u[0] = __uint_as_float(ur.x << 16); u[1] = __uint_as_float(ur.x & 0xffff0000u); u[2] = __uint_as_float(ur.y << 16); u[3] = __uint_as_float(ur.y & 0xffff0000u);
            const f32x4 o = u * (acc[nt] + bias); outv[h][nt] = o; ssq += (o[0] * o[0] + o[1] * o[1]) + (o[2] * o[2] + o[3] * o[3]);
        }
    }
#undef SGU_LOAD
    ssq += shx(ssq, 16, lane); ssq += shx(ssq, 32, lane);
    const float r2 = rsqrtf(ssq * (1.0f / 512.0f) + EPS);
    int orow_r = tc + irow; asm volatile("" : "+v"(orow_r));
    bf16_t* orow = MIX + blk_off(orow_r, X_SGU + 4 * fq);
#pragma unroll
    for (int h = 0; h < 8; ++h)
#pragma unroll
        for (int nt = 0; nt < 4; ++nt) { const f32x4 o = outv[h][nt] * r2; u32x2 w; w.x = cvt_pk_bf16(o[0], o[1]); w.y = cvt_pk_bf16(o[2], o[3]); *(u32x2*)(orow + h * (256 * 64) + 16 * nt) = w; }
}

constexpr int AT_KP = 144, AT_VP = 520;
constexpr float LOG2E = 1.4426950408889634f;
__device__ __forceinline__ void attn_unit(LAS unsigned char* lds, int unit, const bf16_t* PROJ, bf16_t* MIX, float* AST, const float* gq, const float* gk, const float* sinks, int tid_in) {
    int tid = tid_in; asm volatile("" : "+v"(tid));
    const int lane = tid & 63, wave = __builtin_amdgcn_readfirstlane(tid >> 6);
    const int kvh = unit & 3, blk = (unit >> 2) & 15, b = unit >> 6;
    const int tb = b * SEQ + blk * 128, kb = tb - 128, jmin = blk == 0 ? 128 : 0;
    LAS unsigned char* Ks = lds; LAS unsigned char* Vt = lds + 256 * AT_KP; LAS float* ssx = (LAS float*)(lds + 256 * AT_KP + 64 * AT_VP);
    __syncthreads();
#pragma unroll
    for (int it = 0; it < 4; ++it) {
        const int idx = tid + 512 * it, kr = idx >> 3, c8 = idx & 7; const bool valid = kr >= jmin; const int row = valid ? kb + kr : tb;
        const u32x4 raw = *(const u32x4*)(PROJ + (size_t)row * DIN + C_K + kvh * 64 + c8 * 8);
        float v[8];
#pragma unroll
        for (int e = 0; e < 4; ++e) { v[2 * e] = __uint_as_float(raw[e] << 16); v[2 * e + 1] = __uint_as_float(raw[e] & 0xffff0000u); }
        float ss = 0.f;
#pragma unroll
        for (int e = 0; e < 8; ++e) ss += v[e] * v[e];
        ss += shx(ss, 1, lane); ss += shx(ss, 2, lane); ss += shx(ss, 4, lane);
        const float rk = valid ? rsqrtf(ss * (1.0f / 64.0f) + EPS) : 0.f;
        const f32x4 ga = *(const f32x4*)(gk + c8 * 8), gb = *(const f32x4*)(gk + c8 * 8 + 4);
        u32x4 o; o.x = cvt_pk_bf16(v[0] * rk * ga[0], v[1] * rk * ga[1]); o.y = cvt_pk_bf16(v[2] * rk * ga[2], v[3] * rk * ga[3]);
        o.z = cvt_pk_bf16(v[4] * rk * gb[0], v[5] * rk * gb[1]); o.w = cvt_pk_bf16(v[6] * rk * gb[2], v[7] * rk * gb[3]);
        *(LAS u32x4*)(Ks + kr * AT_KP + c8 * 16) = o;
    }
#pragma unroll
    for (int it = 0; it < 8; ++it) {
        const int idx = tid + 512 * it, d = idx & 63, kg = idx >> 6;
        unsigned short x[4];
#pragma unroll
        for (int e = 0; e < 4; ++e) { const int key = 4 * kg + e; const bool valid = key >= jmin; const int row = valid ? kb + key : tb;
            const bf16_t r = PROJ[(size_t)row * DIN + C_V + kvh * 64 + d]; x[e] = valid ? r : (bf16_t)0; }
        u32x2 o; o.x = (unsigned)x[0] | ((unsigned)x[1] << 16); o.y = (unsigned)x[2] | ((unsigned)x[3] << 16);
        *(LAS u32x2*)(Vt + d * AT_VP + kg * 8) = o;
    }
    __syncthreads();
    const int g = wave >> 1, half = wave & 1, h = kvh * 4 + g, q = lane & 31, hh = lane >> 5;
    const float sink2 = sinks[h] * LOG2E;
    u32x4 qraw[2][4];
#pragma unroll
    for (int qt = 0; qt < 2; ++qt) { const bf16_t* qp = PROJ + (size_t)(tb + half * 64 + qt * 32 + q) * DIN + C_Q + h * 64 + 8 * hh;
#pragma unroll
        for (int ks = 0; ks < 4; ++ks) qraw[qt][ks] = *(const u32x4*)(qp + 16 * ks); }
#pragma unroll
    for (int qt = 0; qt < 2; ++qt) {
        const int i0 = half * 64 + qt * 32, i = i0 + q, kt0 = i0 >> 5;
        bf16x8 qf[4];
        {
            float ss = 0.f;
#pragma unroll
            for (int ks = 0; ks < 4; ++ks) {
#pragma unroll
                for (int e = 0; e < 4; ++e) { const float a = __uint_as_float(qraw[qt][ks][e] << 16), c = __uint_as_float(qraw[qt][ks][e] & 0xffff0000u); ss += a * a + c * c; } }
            ss += shx(ss, 32, lane);
            const float rq = rsqrtf(ss * (1.0f / 64.0f) + EPS) * (0.125f * LOG2E);
#pragma unroll
            for (int ks = 0; ks < 4; ++ks) { const f32x4 ga = *(const f32x4*)(gq + 16 * ks + 8 * hh), gb = *(const f32x4*)(gq + 16 * ks + 8 * hh + 4);
                u32x4 o;
#pragma unroll
                for (int e = 0; e < 4; ++e) { const float a = __uint_as_float(qraw[qt][ks][e] << 16), c = __uint_as_float(qraw[qt][ks][e] & 0xffff0000u);
                    const float g0 = e < 2 ? ga[2 * e] : gb[2 * e - 4], g1 = e < 2 ? ga[2 * e + 1] : gb[2 * e - 3]; o[e] = cvt_pk_bf16(a * rq * g0, c * rq * g1); }
                qf[ks] = __builtin_bit_cast(bf16x8, o); }
        }
        f32x16 S[5];
        const LAS unsigned char* kp = Ks + (32 * kt0 + q) * AT_KP + 16 * hh;
#pragma unroll
        for (int kt = 0; kt < 5; ++kt) {
#pragma unroll
            for (int r = 0; r < 16; ++r) S[kt][r] = 0.f;
#pragma unroll
            for (int ks = 0; ks < 4; ++ks) { const bf16x8 kf = *(const LAS bf16x8*)(kp + kt * 32 * AT_KP + ks * 32);
                S[kt] = __builtin_amdgcn_mfma_f32_32x32x16_bf16(kf, qf[ks], S[kt], 0, 0, 0); }
        }
        float mx = -1e30f; const int qa = q - 4 * hh;
#pragma unroll
        for (int kt = 0; kt < 5; ++kt) { const bool tv = 32 * (kt0 + kt) >= jmin;
#pragma unroll
            for (int r = 0; r < 16; ++r) { const int kl = (r & 3) + 8 * (r >> 2);
                bool ok = tv; if (kt == 0) ok = ok && (kl > qa); if (kt == 4) ok = ok && (kl <= qa);
                const float sv = ok ? S[kt][r] : -1e30f; S[kt][r] = sv; mx = fmaxf(mx, sv); } }
        mx = fmaxf(mx, shx(mx, 32, lane)); mx = fmaxf(mx, sink2);
        float sum = 0.f;
#pragma unroll
        for (int kt = 0; kt < 5; ++kt)
#pragma unroll
            for (int r = 0; r < 16; ++r) { const float p = __builtin_amdgcn_exp2f(S[kt][r] - mx); S[kt][r] = p; sum += p; }
        sum += shx(sum, 32, lane);
        const float inv = __builtin_amdgcn_rcpf(sum + __builtin_amdgcn_exp2f(sink2 - mx));
        f32x16 O[2];
#pragma unroll
        for (int r = 0; r < 16; ++r) { O[0][r] = 0.f; O[1][r] = 0.f; }
        const LAS unsigned char* vp = Vt + q * AT_VP + (32 * kt0 + 4 * hh) * 2;
#pragma unroll
        for (int kt = 0; kt < 5; ++kt)
#pragma unroll
            for (int s2 = 0; s2 < 2; ++s2) {
                u32x4 pw; pw.x = cvt_pk_bf16(S[kt][8 * s2 + 0], S[kt][8 * s2 + 1]); pw.y = cvt_pk_bf16(S[kt][8 * s2 + 2], S[kt][8 * s2 + 3]);
                pw.z = cvt_pk_bf16(S[kt][8 * s2 + 4], S[kt][8 * s2 + 5]); pw.w = cvt_pk_bf16(S[kt][8 * s2 + 6], S[kt][8 * s2 + 7]);
                const bf16x8 pf = __builtin_bit_cast(bf16x8, pw);
#pragma unroll
                for (int dt = 0; dt < 2; ++dt) {
                    const u32x2 lo = *(const LAS u32x2*)(vp + dt * 32 * AT_VP + (32 * kt + 16 * s2) * 2), hi2 = *(const LAS u32x2*)(vp + dt * 32 * AT_VP + (32 * kt + 16 * s2 + 8) * 2);
                    u32x4 vw; vw.x = lo.x; vw.y = lo.y; vw.z = hi2.x; vw.w = hi2.y;
                    O[dt] = __builtin_amdgcn_mfma_f32_32x32x16_bf16(__builtin_bit_cast(bf16x8, vw), pf, O[dt], 0, 0, 0);
                }
            }
        float ssq = 0.f;
        bf16_t* op = MIX + blk_off(tb + i, X_ATT + h * 64 + 4 * hh);
#pragma unroll
        for (int dt = 0; dt < 2; ++dt)
#pragma unroll
            for (int g4 = 0; g4 < 4; ++g4) { float o0 = O[dt][4 * g4] * inv, o1 = O[dt][4 * g4 + 1] * inv, o2 = O[dt][4 * g4 + 2] * inv, o3 = O[dt][4 * g4 + 3] * inv;
                ssq += (o0 * o0 + o1 * o1) + (o2 * o2 + o3 * o3); u32x2 w; w.x = cvt_pk_bf16(o0, o1); w.y = cvt_pk_bf16(o2, o3); *(u32x2*)(op + 32 * dt + 8 * g4) = w; }
        ssq += shx(ssq, 32, lane);
        if (hh == 0) ssx[g * 128 + i] = ssq;
    }
    __syncthreads();
    if (tid < 128) AST[(size_t)(tb + tid) * 4 + kvh] = (ssx[tid] + ssx[128 + tid]) + (ssx[256 + tid] + ssx[384 + tid]);
}

constexpr int I_IN = (DM / 64) * (DIN / 64), I_OUT = (DM / 64) * (DM / 64), I_UP = (DM / 64) * (DFF / 64), I_DN = (DFF / 64) * (DM / 64), I_L = I_IN + I_OUT + I_UP + I_DN;
__device__ __forceinline__ void convert_range(const Args& args, unsigned char* ws, int l, int lo_item, int hi_item, int gwi, int ngw, LAS float* scr, int lane) {
    for (int it = lo_item + gwi; it < hi_item; it += ngw) {
        int r = it;
        if (r < I_IN) { p0_transpose_item(args.in[2] + (size_t)l * DM * DIN, args.in[1] + l * DM, DM, DIN, (bf16_t*)(ws + WS_WIN + l * SZ_WIN), scr, r, lane); continue; } r -= I_IN;
        if (r < I_OUT) { p0_transpose_item(args.in[15] + (size_t)l * DM * DM, args.in[14] + l * DM, DM, DM, (bf16_t*)(ws + WS_WOUT + l * SZ_WOUT), scr, r, lane); continue; } r -= I_OUT;
        if (r < I_UP) { p0_transpose_item(args.in[17] + (size_t)l * DM * DFF, args.in[16] + l * DM, DM, DFF, (bf16_t*)(ws + WS_WUP + l * SZ_WUP), scr, r, lane); continue; } r -= I_UP;
        p0_transpose_item(args.in[18] + (size_t)l * DFF * DM, nullptr, DFF, DM, (bf16_t*)(ws + WS_WDN + l * SZ_WDN), scr, r, lane);
    }
}

#define XB_TMO      128
#define XB_XCNT(j)  (256  + 64 * (j))
#define XB_XSUB(j)  (1280 + 64 * (j))
#define XB_XGEN(j)  (2304 + 64 * (j))
#define XB_TOP      3328
#define XB_TOPGEN   3392
#define XCD_BAR_WORDS 3456
#define XB_SPIN_CAP (1u << 18)
__device__ __forceinline__ unsigned xb_ld(unsigned* p)              { return __hip_atomic_load(p, __ATOMIC_RELAXED, __HIP_MEMORY_SCOPE_AGENT); }
__device__ __forceinline__ unsigned xb_add(unsigned* p, unsigned v) { return __hip_atomic_fetch_add(p, v, __ATOMIC_RELAXED, __HIP_MEMORY_SCOPE_AGENT); }
__device__ __forceinline__ unsigned xb_xcc_id() { return (unsigned)__builtin_amdgcn_s_getreg((3 << 11) | 20) & 0xFu; }
#define XB_SPIN(cond, bar) do { unsigned _sp = 0; while (cond) { __builtin_amdgcn_s_sleep(1); \
    if ((++_sp & 255u) == 0u) { if (xb_ld(&(bar)[XB_TMO])) break; if (_sp > XB_SPIN_CAP) { atomicAdd(&(bar)[XB_TMO], 1u); break; } } } } while (0)
struct XcdBarrier { unsigned* bar; unsigned x; volatile LAS unsigned* st; };
__device__ __forceinline__ XcdBarrier xcd_barrier_post(unsigned* bar, volatile LAS unsigned* st) {
    XcdBarrier b; b.bar = bar; b.x = xb_xcc_id(); b.st = st;
    if (threadIdx.x == 0) (void)xb_add(&bar[XB_XCNT(b.x)], 1u);
    return b;
}
__device__ __forceinline__ void xcd_barrier_complete(unsigned* bar, unsigned x, unsigned& nloc, unsigned& nx) {
    const unsigned G = gridDim.x * gridDim.y * gridDim.z;
    unsigned sum, cnt, mine, sp = 0u;
    for (;;) {
        sum = 0u; cnt = 0u; mine = 0u;
#pragma unroll
        for (unsigned j = 0; j < 16; ++j) { const unsigned c = xb_ld(&bar[XB_XCNT(j)]); sum += c; cnt += (c > 0u) ? 1u : 0u; mine = (j == x) ? c : mine; }
        if (sum == G) break;
        __builtin_amdgcn_s_sleep(1);
        if ((++sp & 255u) == 0u) { if (xb_ld(&bar[XB_TMO])) break; if (sp > XB_SPIN_CAP) { atomicAdd(&bar[XB_TMO], 1u); break; } }
    }
    nloc = mine > 0u ? mine : 1u; nx = cnt > 0u ? cnt : 1u;
}
__device__ __forceinline__ void xcd_barrier(const XcdBarrier& b, int wave_s) {
    asm volatile("s_waitcnt vmcnt(0)" ::: "memory");
    __syncthreads();
    if (wave_s == 0 && lane_id() == 0) {
        unsigned* bar = b.bar;
        __builtin_amdgcn_s_waitcnt(0);
        unsigned nloc = b.st[0], nx = b.st[1];
        if (nloc == 0u) { xcd_barrier_complete(bar, b.x, nloc, nx); b.st[0] = nloc; b.st[1] = nx; }
        const unsigned old = xb_add(&bar[XB_XSUB(b.x)], 1u);
        const unsigned gen = old / nloc;
        if (old + 1u == (gen + 1u) * nloc) {
            __builtin_amdgcn_fence(__ATOMIC_RELEASE, "agent");
            asm volatile("s_waitcnt vmcnt(0)" ::: "memory");
            const unsigned og = xb_add(&bar[XB_TOP], 1u);
            const unsigned tg = og / nx;
            if (og + 1u == (tg + 1u) * nx) xb_add(&bar[XB_TOPGEN], 1u);
            else XB_SPIN(xb_ld(&bar[XB_TOPGEN]) == tg, bar);
            __builtin_amdgcn_fence(__ATOMIC_ACQUIRE, "agent");
            xb_add(&bar[XB_XGEN(b.x)], 1u);
            asm volatile("s_waitcnt vmcnt(0)" ::: "memory");
        } else {
            XB_SPIN(xb_ld(&bar[XB_XGEN(b.x)]) == gen, bar);
            __builtin_amdgcn_fence(__ATOMIC_ACQUIRE, "agent");
            asm volatile("s_waitcnt vmcnt(0)" ::: "memory");
        }
    }
    __syncthreads();
}

__global__ void __launch_bounds__(NTHREADS, 2) fwd(Args args) {
    extern __shared__ __attribute__((aligned(16))) unsigned char lds_raw[];
    LAS unsigned char* lds = (LAS unsigned char*)lds_raw;
    const int tid = threadIdx.x, lane = tid & 63, wave = __builtin_amdgcn_readfirstlane(tid >> 6);
    const int G = gridDim.x, bx = blockIdx.x;
    const int gw = bx * NWAVES + wave, NGW = G * NWAVES;
    unsigned char* ws = args.ws;
    bf16_t* XB = (bf16_t*)(ws + WS_XB); bf16_t* PROJ = (bf16_t*)(ws + WS_PROJ); bf16_t* MIX = (bf16_t*)(ws + WS_MIX); bf16_t* HB = (bf16_t*)(ws + WS_H);
    float* RSA = (float*)(ws + WS_RSA); float* RSB = (float*)(ws + WS_RSB); float* AST = (float*)(ws + WS_AST);
    const int lo = args.ph_lo, hi = args.ph_hi;
    const bool split = (G == 256) && (DEPTH == 2);
#if MK_ONE_LAUNCH
    cg::grid_group grid = cg::this_grid();
    volatile LAS unsigned* MISC = (volatile LAS unsigned*)(lds + LDS_BYTES - 64);
    if (tid < 16) MISC[tid] = 0u;
    __syncthreads();
    const XcdBarrier xbar = xcd_barrier_post((unsigned*)(ws + WS_BAR), MISC);
    if (hi > 1000) grid.sync();
#define SEAM(k) do { if ((k) + 1 < hi) xcd_barrier(xbar, wave); } while (0)
#else
#define SEAM(k) do { } while (0)
#endif
#define IN(k) (lo <= (k) && (k) < hi)

    if (IN(0)) {
        LAS float* scr = (LAS float*)(lds + wave * 16640);
        convert_range(args, ws, 0, 0, I_L, gw, NGW, scr, lane);
        if (!split) convert_range(args, ws, 1, 0, I_L, gw, NGW, scr, lane);
        for (int i = bx * NTHREADS + tid; i < DEPTH * 8 * 128 * 128; i += G * NTHREADS) {
            const int ii = (i >> 7) & 127, jj = i & 127; ((bf16_t*)(ws + WS_SGUW))[i] = jj <= ii ? f2bf(args.in[12][i]) : (bf16_t)0; }
        const float* x = args.in[0];
        for (int m = 2 * gw; m < M; m += 2 * NGW) {
            const f32x4* xr = (const f32x4*)(x + (size_t)m * DM) + lane; f32x4 v[16];
#pragma unroll
            for (int j = 0; j < 16; ++j) v[j] = xr[64 * j];
            float ss0 = 0.f, ss1 = 0.f;
#pragma unroll
            for (int j = 0; j < 16; ++j) { const float q = (v[j][0] * v[j][0] + v[j][1] * v[j][1]) + (v[j][2] * v[j][2] + v[j][3] * v[j][3]); if (j < 8) ss0 += q; else ss1 += q;
                u32x2 w; w.x = cvt_pk_bf16(v[j][0], v[j][1]); w.y = cvt_pk_bf16(v[j][2], v[j][3]); *(u32x2*)(XB + blk_off(m + (j >> 3), 4 * lane + 256 * (j & 7))) = w; }
            ss0 = wave_sum(ss0, lane); ss1 = wave_sum(ss1, lane); if (lane == 0) { RSA[m] = ss0; RSA[m + 1] = ss1; }
        }
        SEAM(0);
    }
    for (int l = 0; l < DEPTH; ++l) {
        const int pb = 1 + 5 * l;
        if (IN(pb)) {
            pg8::Gemm g{XB, (const bf16_t*)(ws + WS_WIN + l * SZ_WIN), M, DIN, DM}; pg8::StaticOrder S; S.init(M, DIN, G, bx);
            pg8::EpiScaleBf16<0> E{PROJ, DIN, RSA + (size_t)l * M, 1.0f / DM};
            pg8::gemm_phase<pg8::EpiScaleBf16<0>, false, true, true>(lds, g, S, E, wave);
            if (split && bx >= 128) {
                int t_ = wave * 64 + lane_id(); asm volatile("" : "+v"(t_));
                LAS float* scr = (LAS float*)(lds + wave * 16640);
                if (l == 0) convert_range(args, ws, 1, 0, I_IN + I_OUT + I_UP, (bx - 128) * NWAVES + wave, 128 * NWAVES, scr, t_ & 63);
                else convert_range(args, ws, 1, I_IN + I_OUT + I_UP, I_L, (bx - 128) * NWAVES + wave, 128 * NWAVES, scr, t_ & 63);
            }
            SEAM(pb);
        }
        if (IN(pb + 1)) {
            int t_ = wave * 64 + lane_id(); asm volatile("" : "+v"(t_));
            for (int u = bx; u < 512; u += G) attn_unit(lds, u, PROJ, MIX, AST, args.in[3] + l * 64, args.in[4] + l * 64, args.in[5] + l * 16, t_);
            for (int u = bx; u < 256; u += G) {
                if (u < 128) sgu_unit(lds, u, PROJ, MIX, (const bf16_t*)(ws + WS_SGUW + l * SZ_SGUW), args.in[10] + l * 512, args.in[11] + l * 512, args.in[13] + l * 8 * 128, t_);
                else { conv_unit(lds, 2 * (u - 128), PROJ, MIX, args.in[6] + l * 31 * 512, args.in[7] + l * 512, args.in[8] + l * 512, args.in[9] + l * 512, t_);
                       conv_unit(lds, 2 * (u - 128) + 1, PROJ, MIX, args.in[6] + l * 31 * 512, args.in[7] + l * 512, args.in[8] + l * 512, args.in[9] + l * 512, t_); }
            }
            SEAM(pb + 1);
        }
        if (IN(pb + 2)) {
            pg8::Gemm g{MIX, (const bf16_t*)(ws + WS_WOUT + l * SZ_WOUT), M, DM, DM}; pg8::StaticOrder S; S.init(M, DM, G, bx);
            pg8::EpiRes<16, false> E{XB, nullptr, RSB + (size_t)l * M, AST, DM};
            pg8::gemm_phase<pg8::EpiRes<16, false>, false, true, true>(lds, g, S, E, wave);
            SEAM(pb + 2);
        }
        if (IN(pb + 3)) {
            pg8::Gemm g{XB, (const bf16_t*)(ws + WS_WUP + l * SZ_WUP), M, DFF, DM}; pg8::StaticOrder S; S.init(M, DFF, G, bx);
            pg8::EpiScaleBf16<1, true> E{HB, DFF, RSB + (size_t)l * M, 1.0f / DM};
            pg8::gemm_phase<pg8::EpiScaleBf16<1, true>, false, true, true>(lds, g, S, E, wave);
            SEAM(pb + 3);
        }
        if (IN(pb + 4)) {
            pg8::Gemm g{HB, (const bf16_t*)(ws + WS_WDN + l * SZ_WDN), M, DM, DFF}; pg8::StaticOrder S; S.init(M, DM, G, bx, 1);
            if (l == DEPTH - 1) { pg8::EpiRes<0, true> E{XB, args.out, nullptr, nullptr, DM}; pg8::gemm_phase<pg8::EpiRes<0, true>, false, true, true>(lds, g, S, E, wave); }
            else { pg8::EpiRes<0, false> E{XB, nullptr, RSA + (size_t)(l + 1) * M, nullptr, DM}; pg8::gemm_phase<pg8::EpiRes<0, false>, false, true, true>(lds, g, S, E, wave); }
            SEAM(pb + 4);
        }
    }
#undef IN
#undef SEAM
}

constexpr int NPHASES = 1 + 5 * DEPTH;

extern "C" void kernel_launch(void* const* d_in, const int* in_sizes, int n_in, void* d_out, int out_size, void* d_ws, size_t ws_size, hipStream_t stream) {
    static int grid = 0;
    if (grid == 0) {
        if (n_in != 19 || in_sizes[0] != M * DM || out_size != M * DM || ws_size < WS_END) {
            fprintf(stderr, "kernel_launch: unexpected shapes (n_in %d, in0 %d, out %d, ws %zu need %zu); nothing launched\n", n_in, n_in > 0 ? in_sizes[0] : -1, out_size, ws_size, (size_t)WS_END); grid = -1; return; }
        int dev = 0, cus = 0, per_cu = 0;
        (void)hipGetDevice(&dev); (void)hipDeviceGetAttribute(&cus, hipDeviceAttributeMultiprocessorCount, dev);
        if (hipFuncSetAttribute((const void*)fwd, hipFuncAttributeMaxDynamicSharedMemorySize, LDS_BYTES) != hipSuccess) { fprintf(stderr, "kernel_launch: hipFuncSetAttribute failed\n"); grid = -1; return; }
        (void)hipOccupancyMaxActiveBlocksPerMultiprocessor(&per_cu, (const void*)fwd, NTHREADS, LDS_BYTES);
        if (per_cu < 1) fprintf(stderr, "kernel_launch: occupancy query says %d blocks per CU\n", per_cu);
        (void)hipGetLastError();
        grid = cus > 0 ? cus : 256;
    }
    if (grid < 0) return;
    (void)hipMemsetAsync((unsigned char*)d_ws + WS_BAR, 0, 16384 + (size_t)(2 * DEPTH) * M * 4, stream);
    Args a{};
    for (int i = 0; i < 19; ++i) a.in[i] = (const float*)d_in[i];
    a.out = (float*)d_out; a.ws = (unsigned char*)d_ws;
#if MK_ONE_LAUNCH
    a.ph_lo = 0; a.ph_hi = NPHASES;
    void* kargs[] = {&a};
    hipError_t e = hipLaunchCooperativeKernel((const void*)fwd, dim3(grid), dim3(NTHREADS), kargs, LDS_BYTES, stream);
    if (e != hipSuccess) fprintf(stderr, "cooperative launch failed: %s (grid %d)\n", hipGetErrorString(e), grid);
#else
    for (int p = 0; p < NPHASES; ++p) {
        a.ph_lo = p; a.ph_hi = p + 1;
        hipLaunchKernelGGL(fwd, dim3(grid), dim3(NTHREADS), LDS_BYTES, stream, a);
    }
#endif
}
```

```cpp
#include <hip/hip_runtime.h>
#include <hip/hip_cooperative_groups.h>
#include <cstdio>
#include <cstdint>
namespace cg = cooperative_groups;

#ifndef MK_ONE_LAUNCH
#define MK_ONE_LAUNCH 1
#endif

constexpr int DM = 2048, SEQ = 2048, NB = 8, M = NB * SEQ, DIN = 3584, DFF = 8192, DEPTH = 2;
constexpr int C_Q = 0, C_K = 1024, C_V = 1280, C_CA = 1536, C_CG = 2048, C_SU = 2560, C_SV = 3072;
constexpr int X_ATT = 0, X_CONV = 1024, X_SGU = 1536;
constexpr float EPS = 1e-6f;

#define LAS __attribute__((address_space(3)))
typedef unsigned short bf16_t;
typedef short bf16x8 __attribute__((ext_vector_type(8)));
typedef float f32x4 __attribute__((ext_vector_type(4)));
typedef unsigned u32x4 __attribute__((ext_vector_type(4)));
typedef unsigned u32x2 __attribute__((ext_vector_type(2)));

__device__ __forceinline__ unsigned cvt_pk_bf16(float lo, float hi) { unsigned r; asm volatile("v_cvt_pk_bf16_f32 %0, %1, %2" : "=v"(r) : "v"(lo), "v"(hi)); return r; }
__device__ __forceinline__ float bf2f(bf16_t b) { return __uint_as_float(((unsigned)b) << 16); }
__device__ __forceinline__ bf16_t f2bf(float f) { return (bf16_t)(cvt_pk_bf16(f, 0.f) & 0xffffu); }
__device__ __forceinline__ int lane_id() { int x; asm volatile("v_mbcnt_lo_u32_b32 %0, -1, 0\n\tv_mbcnt_hi_u32_b32 %0, -1, %0" : "=v"(x)); return x; }
__device__ __forceinline__ float shx(float v, int o, int lane) { return __int_as_float(__builtin_amdgcn_ds_bpermute((lane ^ o) << 2, __float_as_int(v))); }
__device__ __forceinline__ float shl(float v, int src) { return __int_as_float(__builtin_amdgcn_ds_bpermute(src << 2, __float_as_int(v))); }
__device__ __forceinline__ float wave_sum(float v, int lane) {
#pragma unroll
    for (int o = 1; o < 64; o <<= 1) v += shx(v, o, lane);
    return v;
}
__device__ __forceinline__ float wave_max(float v, int lane) {
#pragma unroll
    for (int o = 1; o < 64; o <<= 1) v = fmaxf(v, shx(v, o, lane));
    return v;
}

__device__ __forceinline__ size_t blk_off(int row, int col) { return (((size_t)(row >> 8) * (DM / 64) + (col >> 6)) * 256 + (row & 255)) * 64 + (col & 63); }

namespace pg8 {
constexpr int BM = 256, BK = 64, HALF = 128, HTB = HALF * BK * 2, STAGE_BYTES = 8 * HTB, NXCD = 8, WGM = 8;
__host__ __device__ __forceinline__ int lds_byte(int r, int c) { const int st = (r >> 4) * 2 + (c >> 5), rr = r & 15, cc = c & 31, ob = rr * 64 + cc * 2; return st * 1024 + (ob ^ (((ob >> 9) & 1) << 5)); }
__host__ __device__ __forceinline__ void stage_rc(int b, int& R, int& C) { const int st = b / 1024, sb = b % 1024, swz = sb ^ (((sb >> 9) & 1) << 5); R = (st >> 1) * 16 + swz / 64; C = (st & 1) * 32 + (swz % 64) / 2; }
__host__ __device__ __forceinline__ int perm32(int rho) { const int n = rho >> 4, i = rho & 15; return 8 * (i >> 2) + 4 * n + (i & 3); }

struct Unit { int pm, pn; };
struct Gemm { const bf16_t* A; const bf16_t* Bt; int M, N, K; };

struct StaticOrder {
    int nM, nN, nwg, G, c, pnfast;
    __host__ __device__ void init(int M_, int N_, int G_, int c_, int pnfast_ = 0) { nM = M_ / BM; nN = N_ / BM; nwg = nM * nN; G = G_; c = c_; pnfast = pnfast_; }
    __host__ __device__ bool next(int i, Unit& u) const {
        const long L = (long)i * G + c; if (L >= nwg) return false;
        int wgid = (int)L; { const int q = nwg / NXCD, r = nwg % NXCD, xcd = wgid % NXCD, off = wgid / NXCD; wgid = (xcd < r ? xcd * (q + 1) : r * (q + 1) + (xcd - r) * q) + off; }
        const int nig = WGM * nN, gid = wgid / nig, fm = gid * WGM, gsz = (nM - fm) < WGM ? (nM - fm) : WGM;
        if (pnfast == 2) { const int j = wgid % nig, rnd = j >> 5, k = j & 31; u.pn = 8 * (rnd >> 1) + (k & 7); u.pm = fm + 4 * (rnd & 1) + (k >> 3); }
        else if (pnfast) { u.pn = (wgid % nig) % nN; u.pm = fm + (wgid % nig) / nN; } else { u.pm = fm + ((wgid % nig) % gsz); u.pn = (wgid % nig) / gsz; }
        return true;
    }
};

template <int ACT, bool OBLK = false> struct EpiScaleBf16 {
    static constexpr bool PERM = true; static constexpr int MID_T = 0;
    bf16_t* O; int ldc; const float* rowss; float inv_n;
    __device__ __forceinline__ void mid(f32x4 (&)[2][2][4][2], const Unit&, int, int) const {}
    __device__ __forceinline__ void prefetch(float (&pre)[8], const Unit& u, int wr, int fr) const {
        const float* p = rowss + u.pm * BM + wr * 64 + fr;
#pragma unroll
        for (int ai = 0; ai < 2; ++ai)
#pragma unroll
            for (int m = 0; m < 4; ++m) pre[ai * 4 + m] = p[ai * HALF + m * 16];
    }
    __device__ __forceinline__ void operator()(const f32x4 (&acc)[2][2][4][2], const float (&pre)[8], const Unit& u, int wr, int wc, int fr, int fq) const {
        const int row0 = u.pm * BM + wr * 64 + fr; const int col0 = u.pn * BM + wc * 32 + 8 * fq;
#pragma unroll
        for (int ai = 0; ai < 2; ++ai)
#pragma unroll
            for (int m = 0; m < 4; ++m) { const int row = row0 + ai * HALF + m * 16; const float rs = rsqrtf(pre[ai * 4 + m] * inv_n + EPS);
                bf16_t* rowp = OBLK ? O + (((size_t)u.pm * (ldc >> 6) + (col0 >> 6)) * 256 + (row & 255)) * 64 + (col0 & 63) : O + (size_t)row * ldc + col0;
#pragma unroll
                for (int bj = 0; bj < 2; ++bj) { f32x4 v0 = acc[ai][bj][m][0] * rs, v1 = acc[ai][bj][m][1] * rs;
                    if (ACT == 1) {
#pragma unroll
                        for (int e = 0; e < 4; ++e) { float a = fmaxf(v0[e], 0.f), b = fmaxf(v1[e], 0.f); v0[e] = a * a; v1[e] = b * b; } }
                    u32x4 w; w.x = cvt_pk_bf16(v0[0], v0[1]); w.y = cvt_pk_bf16(v0[2], v0[3]); w.z = cvt_pk_bf16(v1[0], v1[1]); w.w = cvt_pk_bf16(v1[2], v1[3]);
                    *(u32x4*)(rowp + (OBLK ? bj * (HALF / 64) * 256 * 64 : bj * HALF)) = w; } }
    }
};
template <int MIDT, bool FINAL> struct EpiRes {
    static constexpr bool PERM = true; static constexpr int MID_T = MIDT;
    bf16_t* xb; float* outf; float* rowss_out; const float* astat; int ldc;
    __device__ __forceinline__ void mid(f32x4 (&acc)[2][2][4][2], const Unit& u, int wr, int fr) const {
        const int row0 = u.pm * BM + wr * 64 + fr;
#pragma unroll
        for (int ai = 0; ai < 2; ++ai)
#pragma unroll
            for (int m = 0; m < 4; ++m) { const int row = row0 + ai * HALF + m * 16; const f32x4 s = *(const f32x4*)(astat + (size_t)row * 4);
                const float r1 = rsqrtf(((s[0] + s[1]) + (s[2] + s[3])) * (1.0f / 1024.0f) + EPS);
#pragma unroll
                for (int bj = 0; bj < 2; ++bj)
#pragma unroll
                    for (int n = 0; n < 2; ++n) acc[ai][bj][m][n] = acc[ai][bj][m][n] * r1;
                asm volatile("" ::: "memory"); }
    }
    __device__ __forceinline__ void prefetch(float (&)[8], const Unit&, int, int) const {}
    __device__ __forceinline__ void operator()(const f32x4 (&acc)[2][2][4][2], const float (&)[8], const Unit& u, int wr, int wc, int fr, int fq) const {
        const int row0 = u.pm * BM + wr * 64 + fr; const int col0 = u.pn * BM + wc * 32 + 8 * fq, lane = fr + 16 * fq;
        u32x4 bv[2][4][2];
#pragma unroll
        for (int ai = 0; ai < 2; ++ai)
#pragma unroll
            for (int m = 0; m < 4; ++m) { const bf16_t* rp = xb + blk_off(row0 + ai * HALF + m * 16, col0);
#pragma unroll
                for (int bj = 0; bj < 2; ++bj) bv[ai][m][bj] = *(const u32x4*)(rp + bj * (2 * 256 * 64)); }
#pragma unroll
        for (int ai = 0; ai < 2; ++ai)
#pragma unroll
            for (int m = 0; m < 4; ++m) { const int row = row0 + ai * HALF + m * 16; const size_t off = (size_t)row * ldc + col0; float ss = 0.f;
#pragma unroll
                for (int bj = 0; bj < 2; ++bj) { const u32x4 b = bv[ai][m][bj]; f32x4 o0, o1;
                    o0[0] = __uint_as_float(b.x << 16); o0[1] = __uint_as_float(b.x & 0xffff0000u); o0[2] = __uint_as_float(b.y << 16); o0[3] = __uint_as_float(b.y & 0xffff0000u);
                    o1[0] = __uint_as_float(b.z << 16); o1[1] = __uint_as_float(b.z & 0xffff0000u); o1[2] = __uint_as_float(b.w << 16); o1[3] = __uint_as_float(b.w & 0xffff0000u);
                    o0 = o0 + acc[ai][bj][m][0]; o1 = o1 + acc[ai][bj][m][1];
                    if (FINAL) { *(f32x4*)(outf + off + bj * HALF) = o0; *(f32x4*)(outf + off + bj * HALF + 4) = o1; }
                    else { u32x4 w; w.x = cvt_pk_bf16(o0[0], o0[1]); w.y = cvt_pk_bf16(o0[2], o0[3]); w.z = cvt_pk_bf16(o1[0], o1[1]); w.w = cvt_pk_bf16(o1[2], o1[3]);
                        *(u32x4*)(xb + blk_off(row, col0) + bj * (2 * 256 * 64)) = w; }
                    ss += ((o0[0] * o0[0] + o0[1] * o0[1]) + (o0[2] * o0[2] + o0[3] * o0[3])) + ((o1[0] * o1[0] + o1[1] * o1[1]) + (o1[2] * o1[2] + o1[3] * o1[3])); }
                if (!FINAL) { if (rowss_out) { ss += shx(ss, 16, lane); ss += shx(ss, 32, lane); if (fq == 0) atomicAdd(rowss_out + row, ss); } } }
    }
};

template <class Epi, bool ALIGN_EPI, bool ABLK = false, bool BBLK = false>
__device__ __forceinline__ void gemm_phase(LAS unsigned char* lds, const Gemm g, const StaticOrder& S, const Epi& E, int wave_s) {
    int tid = wave_s * 64 + lane_id(); asm volatile("" : "+v"(tid));
    const int wid = __builtin_amdgcn_readfirstlane(tid >> 6), lane = tid & 63, wr = wid >> 2, wc = wid & 3, fr = lane & 15, fq = lane >> 4;
    const int K = g.K, nt = K / BK;
    unsigned voffA, voffB;
    const int pitchA = ABLK ? 64 : K, pitchB = BBLK ? 64 : K;
    { int R, C; stage_rc(tid * 16, R, C); const int Rb = Epi::PERM ? ((R & ~31) + perm32(R & 31)) : R; voffA = (unsigned)(R * pitchA + C) * 2u; voffB = (unsigned)(Rb * pitchB + C) * 2u; }
    const size_t r64A = (size_t)64 * pitchA * 2, r64B = (size_t)64 * pitchB * 2;
    const size_t kstepA = ABLK ? (size_t)(BM * BK * 2) : (size_t)(BK * 2), kstepB = BBLK ? (size_t)(BM * BK * 2) : (size_t)(BK * 2);
    const size_t hstepA = (size_t)HALF * pitchA * 2, hstepB = (size_t)HALF * pitchB * 2;
    const size_t tstep = (size_t)BM * K * 2;
    const unsigned ldsw = (unsigned)wid * 1024u;
    const int aoff = lds_byte(wr * 64 + fr, fq * 8), boff = lds_byte(wc * 32 + fr, fq * 8);
#define PG8_SA(b, h) (((b) * 2 + (h)) * HTB)
#define PG8_SB(b, h) ((4 + (b) * 2 + (h)) * HTB)
#define PG8_STAGE(bufoff, gbase, voff, r64) do { _Pragma("unroll") for (int _i = 0; _i < 2; ++_i) \
        __builtin_amdgcn_global_load_lds((const unsigned*)((const char*)(gbase) + _i * r64 + (voff)), (LAS unsigned*)(lds + (bufoff) + ldsw + _i * 8192), 16, 0, 0); } while (0)
#define PG8_LDA(dst, b, h) do { _Pragma("unroll") for (int m = 0; m < 4; ++m) _Pragma("unroll") for (int k = 0; k < 2; ++k) dst[m][k] = *(const LAS bf16x8*)(lds + PG8_SA(b, h) + aoff + m * 2048 + k * 1024); } while (0)
#define PG8_LDB(dst, b, h) do { _Pragma("unroll") for (int n = 0; n < 2; ++n) _Pragma("unroll") for (int k = 0; k < 2; ++k) dst[n][k] = *(const LAS bf16x8*)(lds + PG8_SB(b, h) + boff + n * 2048 + k * 1024); } while (0)
#define PG8_MMA(ai, bj, At, Bt) do { __builtin_amdgcn_s_setprio(1); _Pragma("unroll") for (int m = 0; m < 4; ++m) _Pragma("unroll") for (int n = 0; n < 2; ++n) _Pragma("unroll") for (int k = 0; k < 2; ++k) \
        acc[ai][bj][m][n] = __builtin_amdgcn_mfma_f32_16x16x32_bf16(Bt[n][k], At[m][k], acc[ai][bj][m][n], 0, 0, 0); __builtin_amdgcn_s_setprio(0); } while (0)
#define PG8_WAIT_V(n) asm volatile("s_waitcnt vmcnt(" #n ")" ::: "memory")
#define PG8_WAIT_L(n) asm volatile("s_waitcnt lgkmcnt(" #n ")" ::: "memory")
#define PG8_BAR __builtin_amdgcn_s_barrier()
#define PG8_SCHED __builtin_amdgcn_sched_barrier(0)
    Unit cur, nxt; int ui = 0;
    if (!S.next(0, cur)) return;
    f32x4 acc[2][2][4][2];
#pragma unroll
    for (int a = 0; a < 2; ++a)
#pragma unroll
        for (int b = 0; b < 2; ++b)
#pragma unroll
            for (int m = 0; m < 4; ++m)
#pragma unroll
                for (int n = 0; n < 2; ++n) acc[a][b][m][n] = (f32x4){0.f, 0.f, 0.f, 0.f};
    bf16x8 At[4][2], B0[2][2], B1[2][2];
    float pre[8];
#pragma unroll
    for (int k = 0; k < 8; ++k) pre[k] = 0.f;
    const char* cA = (const char*)g.A + (size_t)cur.pm * tstep; const char* cB = (const char*)g.Bt + (size_t)cur.pn * tstep;
    PG8_STAGE(PG8_SB(0, 0), cB, voffB, r64B); PG8_STAGE(PG8_SB(0, 1), cB + hstepB, voffB, r64B); PG8_STAGE(PG8_SA(0, 0), cA, voffA, r64A); PG8_STAGE(PG8_SA(0, 1), cA + hstepA, voffA, r64A);
    PG8_STAGE(PG8_SB(1, 0), cB + kstepB, voffB, r64B); PG8_STAGE(PG8_SA(1, 0), cA + kstepA, voffA, r64A); PG8_STAGE(PG8_SB(1, 1), cB + hstepB + kstepB, voffB, r64B);
    if (wr == 1) PG8_BAR;
    PG8_WAIT_V(8); PG8_BAR;
    PG8_WAIT_V(6); PG8_BAR;
    for (;;) {
        const bool has_next = S.next(ui + 1, nxt);
        const char* nA = has_next ? (const char*)g.A + (size_t)nxt.pm * tstep : cA; const char* nB = has_next ? (const char*)g.Bt + (size_t)nxt.pn * tstep : cB;
        for (int t = 0; t < nt; t += 2) {
            if constexpr (Epi::MID_T > 0) { if (t == Epi::MID_T) E.mid(acc, cur, wr, fr); }
            const bool last = (t == nt - 2);
            if (last) E.prefetch(pre, cur, wr, fr);
            const char* a1 = cA + (size_t)(t + 1) * kstepA;
            const char* a2 = last ? nA : cA + (size_t)(t + 2) * kstepA; const char* b2 = last ? nB : cB + (size_t)(t + 2) * kstepB;
            const char* a3 = a2 + kstepA; const char* b3 = b2 + kstepB;
            PG8_LDB(B0, 0, 0); PG8_LDB(B1, 0, 1); PG8_SCHED; PG8_LDA(At, 0, 0); PG8_STAGE(PG8_SA(1, 1), a1 + hstepA, voffA, r64A);
            PG8_WAIT_V(8); PG8_WAIT_L(0); PG8_BAR; PG8_MMA(0, 0, At, B0); PG8_MMA(0, 1, At, B1); PG8_BAR; PG8_SCHED;
            PG8_LDA(At, 0, 1); PG8_STAGE(PG8_SB(0, 0), b2, voffB, r64B); PG8_STAGE(PG8_SB(0, 1), b2 + hstepB, voffB, r64B); PG8_STAGE(PG8_SA(0, 0), a2, voffA, r64A);
            PG8_WAIT_V(8); PG8_WAIT_L(0); PG8_BAR; PG8_MMA(1, 0, At, B0); PG8_MMA(1, 1, At, B1); PG8_BAR; PG8_SCHED;
            PG8_LDB(B0, 1, 0); PG8_LDB(B1, 1, 1); PG8_SCHED; PG8_LDA(At, 1, 0); PG8_STAGE(PG8_SA(0, 1), a2 + hstepA, voffA, r64A);
            PG8_WAIT_V(8); PG8_WAIT_L(0); PG8_BAR; PG8_MMA(0, 0, At, B0); PG8_MMA(0, 1, At, B1); PG8_BAR; PG8_SCHED;
            PG8_LDA(At, 1, 1); PG8_STAGE(PG8_SB(1, 0), b3, voffB, r64B); PG8_STAGE(PG8_SB(1, 1), b3 + hstepB, voffB, r64B); PG8_STAGE(PG8_SA(1, 0), a3, voffA, r64A);
            PG8_WAIT_V(8); PG8_WAIT_L(0); PG8_BAR; PG8_MMA(1, 0, At, B0); PG8_MMA(1, 1, At, B1); PG8_BAR; PG8_SCHED;
        }
        if constexpr (ALIGN_EPI) { if (wr == 0) PG8_BAR; }
        E(acc, pre, cur, wr, wc, fr, fq);
        if (!has_next) break;
#pragma unroll
        for (int a = 0; a < 2; ++a)
#pragma unroll
            for (int b = 0; b < 2; ++b)
#pragma unroll
                for (int m = 0; m < 4; ++m)
#pragma unroll
                    for (int n = 0; n < 2; ++n) acc[a][b][m][n] = (f32x4){0.f, 0.f, 0.f, 0.f};
        cur = nxt; cA = nA; cB = nB; ++ui;
        if constexpr (ALIGN_EPI) { if (wr == 1) PG8_BAR; }
    }
    PG8_WAIT_V(0);
    if constexpr (!ALIGN_EPI) { if (wr == 0) PG8_BAR; }
    PG8_BAR;
#undef PG8_SA
#undef PG8_SB
#undef PG8_STAGE
#undef PG8_LDA
#undef PG8_LDB
#undef PG8_MMA
#undef PG8_WAIT_V
#undef PG8_WAIT_L
#undef PG8_BAR
#undef PG8_SCHED
}
}

constexpr int NWAVES = 8, NTHREADS = 512;
constexpr int RING_BYTES = 131072, LDS_BYTES = 147456;
constexpr size_t MiB = 1u << 20;
constexpr size_t SZ_WIN = (size_t)DIN * DM * 2, SZ_WOUT = (size_t)DM * DM * 2, SZ_WUP = (size_t)DFF * DM * 2, SZ_WDN = (size_t)DM * DFF * 2, SZ_SGUW = (size_t)8 * 128 * 128 * 2;
constexpr size_t WS_WIN = 0;
constexpr size_t WS_WOUT = WS_WIN + DEPTH * SZ_WIN;
constexpr size_t WS_WUP = WS_WOUT + DEPTH * SZ_WOUT;
constexpr size_t WS_WDN = WS_WUP + DEPTH * SZ_WUP;
constexpr size_t WS_SGUW = WS_WDN + DEPTH * SZ_WDN;
constexpr size_t WS_BAR = WS_SGUW + DEPTH * SZ_SGUW;
constexpr size_t WS_RSA = WS_BAR + 16384;
constexpr size_t WS_RSB = WS_RSA + (size_t)DEPTH * M * 4;
constexpr size_t WS_AST = WS_RSB + (size_t)DEPTH * M * 4;
constexpr size_t WS_XB = WS_AST + (size_t)M * 16;
constexpr size_t WS_R = WS_XB + (size_t)M * DM * 2;
constexpr size_t WS_PROJ = WS_R, WS_MIX = WS_R + (size_t)M * DIN * 2, WS_H = WS_R;
constexpr size_t WS_END = WS_R + (size_t)M * DFF * 2;
static_assert(WS_XB % 256 == 0 && WS_R % 256 == 0 && WS_MIX % 256 == 0, "alignment");

struct Args { const float* in[19]; float* out; unsigned char* ws; int ph_lo, ph_hi; };

__device__ __forceinline__ void p0_transpose_item(const float* W, const float* gain, int K, int N, bf16_t* WT, LAS float* scr, int item, int lane) {
    const int nblk = N / 64, kb = item / nblk, nb = item % nblk, k0 = 64 * kb, n0 = 64 * nb;
    const int kq = lane >> 4, col = 4 * (lane & 15);
    const float* src = W + (size_t)(k0 + kq) * N + n0 + col;
    f32x4 v[16];
#pragma unroll
    for (int i = 0; i < 16; ++i) v[i] = *(const f32x4*)(src + (size_t)(4 * i) * N);
    if (gain) {
#pragma unroll
        for (int i = 0; i < 16; ++i) v[i] = v[i] * gain[k0 + 4 * i + kq];
    }
#pragma unroll
    for (int i = 0; i < 16; ++i) { LAS float* d = scr + (4 * i + kq) * 65 + col; d[0] = v[i][0]; d[1] = v[i][1]; d[2] = v[i][2]; d[3] = v[i][3]; }
    asm volatile("s_waitcnt lgkmcnt(0)" ::: "memory");
    const int c = lane & 7;
#pragma unroll
    for (int j = 0; j < 8; ++j) { const int n = (lane >> 3) + 8 * j; const LAS float* s = scr + (8 * c) * 65 + n;
        u32x4 o; o.x = cvt_pk_bf16(s[0 * 65], s[1 * 65]); o.y = cvt_pk_bf16(s[2 * 65], s[3 * 65]); o.z = cvt_pk_bf16(s[4 * 65], s[5 * 65]); o.w = cvt_pk_bf16(s[6 * 65], s[7 * 65]);
        const int na = n0 + n; *(u32x4*)(WT + ((size_t)((na >> 8) * (K >> 6) + kb) * 256 + (na & 255)) * 64 + 8 * c) = o; }
    asm volatile("s_waitcnt lgkmcnt(0)" ::: "memory");
}

typedef float f32x16 __attribute__((ext_vector_type(16)));
__device__ __forceinline__ float sigm(float x) { return __builtin_amdgcn_rcpf(1.0f + __expf(-x)); }

typedef float f32x2 __attribute__((ext_vector_type(2)));
__device__ __forceinline__ void conv_unit(LAS unsigned char* lds, int unit, const bf16_t* PROJ, bf16_t* MIX, const float* cw, const float* cb, const float* lng, const float* lnb, int tid_in) {
    int tid = tid_in; asm volatile("" : "+v"(tid));
    const int lane = tid & 63, wave = tid >> 6;
    const int tb = unit * 64, s0 = tb & (SEQ - 1), blk = wave >> 2, c0 = 128 * (wave & 3) + 2 * lane;
    LAS float* cv = (LAS float*)lds;
    __syncthreads();
    {
        f32x2 w[31];
#pragma unroll
        for (int j = 0; j < 31; ++j) w[j] = *(const f32x2*)(cw + j * 512 + c0);
        const f32x2 bias = *(const f32x2*)(cb + c0);
        f32x2 acc[32];
#pragma unroll
        for (int o = 0; o < 32; ++o) acc[o] = bias;
        const int p0 = s0 + blk * 32 - 30;
        const bf16_t* rp = PROJ + ((ptrdiff_t)(tb + blk * 32 - 30) * DIN + c0);
        unsigned ra[2][16], rg[2][16];
#pragma unroll
        for (int k = 0; k < 16; ++k) { ra[0][k] = *(const unsigned*)(rp + (ptrdiff_t)k * DIN + C_CA); rg[0][k] = *(const unsigned*)(rp + (ptrdiff_t)k * DIN + C_CG); }
#pragma unroll
        for (int gi = 0; gi < 4; ++gi) {
            rp += 16 * DIN; asm volatile("" : "+v"(rp));
            if (gi < 3) {
#pragma unroll
                for (int k = 0; k < 16; ++k) if (gi * 16 + 16 + k < 62) { ra[(gi + 1) & 1][k] = *(const unsigned*)(rp + (ptrdiff_t)k * DIN + C_CA); rg[(gi + 1) & 1][k] = *(const unsigned*)(rp + (ptrdiff_t)k * DIN + C_CG); }
            }
#pragma unroll
            for (int k = 0; k < 16; ++k) { const int ii = gi * 16 + k; if (ii < 62) {
                const unsigned a = ra[gi & 1][k], gt = rg[gi & 1][k];
                f32x2 hv; hv.x = __uint_as_float(a << 16) * sigm(__uint_as_float(gt << 16)); hv.y = __uint_as_float(a & 0xffff0000u) * sigm(__uint_as_float(gt & 0xffff0000u));
                if ((p0 + ii) < 0) hv = (f32x2){0.f, 0.f};
#pragma unroll
                for (int o = 0; o < 32; ++o) { const int j = ii - o; if (j >= 0 && j <= 30) acc[o] += w[j] * hv; } } }
        }
        LAS float* cvb = cv + blk * 32 * 512 + c0; asm volatile("" : "+v"(cvb));
#pragma unroll
        for (int o = 0; o < 32; ++o) *(LAS f32x2*)(cvb + o * 512) = acc[o];
    }
    __syncthreads();
    {
        const f32x4 g0 = *(const f32x4*)(lng + 4 * lane), g1 = *(const f32x4*)(lng + 256 + 4 * lane), b0 = *(const f32x4*)(lnb + 4 * lane), b1 = *(const f32x4*)(lnb + 256 + 4 * lane);
        f32x4 v0[8], v1[8]; float red[8];
        const LAS float* cvr = cv + wave * 8 * 512 + 4 * lane;
#pragma unroll
        for (int r = 0; r < 8; ++r) { v0[r] = *(const LAS f32x4*)(cvr + r * 512); v1[r] = *(const LAS f32x4*)(cvr + r * 512 + 256);
            red[r] = ((v0[r][0] + v0[r][1]) + (v0[r][2] + v0[r][3])) + ((v1[r][0] + v1[r][1]) + (v1[r][2] + v1[r][3])); }
#pragma unroll
        for (int o = 1; o < 64; o <<= 1)
#pragma unroll
            for (int r = 0; r < 8; ++r) red[r] += shx(red[r], o, lane);
#pragma unroll
        for (int r = 0; r < 8; ++r) { const float mean = red[r] * (1.0f / 512.0f); v0[r] = v0[r] - mean; v1[r] = v1[r] - mean;
            red[r] = ((v0[r][0] * v0[r][0] + v0[r][1] * v0[r][1]) + (v0[r][2] * v0[r][2] + v0[r][3] * v0[r][3])) + ((v1[r][0] * v1[r][0] + v1[r][1] * v1[r][1]) + (v1[r][2] * v1[r][2] + v1[r][3] * v1[r][3])); }
#pragma unroll
        for (int o = 1; o < 64; o <<= 1)
#pragma unroll
            for (int r = 0; r < 8; ++r) red[r] += shx(red[r], o, lane);
#pragma unroll
        for (int r = 0; r < 8; ++r) { const float rstd = rsqrtf(red[r] * (1.0f / 512.0f) + EPS); v0[r] = v0[r] * rstd * g0 + b0; v1[r] = v1[r] * rstd * g1 + b1; float q2 = 0.f;
#pragma unroll
            for (int e = 0; e < 4; ++e) { v0[r][e] = v0[r][e] * sigm(v0[r][e]); v1[r][e] = v1[r][e] * sigm(v1[r][e]); q2 += v0[r][e] * v0[r][e] + v1[r][e] * v1[r][e]; }
            red[r] = q2; }
#pragma unroll
        for (int o = 1; o < 64; o <<= 1)
#pragma unroll
            for (int r = 0; r < 8; ++r) red[r] += shx(red[r], o, lane);
        bf16_t* orow = MIX + blk_off(tb + wave * 8, X_CONV + 4 * lane);
#pragma unroll
        for (int r = 0; r < 8; ++r) { const float r2 = rsqrtf(red[r] * (1.0f / 512.0f) + EPS); const f32x4 a = v0[r] * r2, c = v1[r] * r2;
            u32x2 o0, o1; o0.x = cvt_pk_bf16(a[0], a[1]); o0.y = cvt_pk_bf16(a[2], a[3]); o1.x = cvt_pk_bf16(c[0], c[1]); o1.y = cvt_pk_bf16(c[2], c[3]);
            *(u32x2*)(orow + r * 64) = o0; *(u32x2*)(orow + r * 64 + 4 * 256 * 64) = o1; }
    }
}

constexpr int SG_P = 136;
__device__ __forceinline__ void sgu_unit(LAS unsigned char* lds, int unit, const bf16_t* PROJ, bf16_t* MIX, const bf16_t* SW, const float* lng, const float* lnb, const float* sb, int tid_in) {
    int tid = tid_in; asm volatile("" : "+v"(tid));
    const int lane = tid & 63, wave = __builtin_amdgcn_readfirstlane(tid >> 6);
    const int tc = unit * 128;
    LAS bf16_t* Vt = (LAS bf16_t*)lds;
    LAS float* st = (LAS float*)(lds + 512 * SG_P * 2);
    __syncthreads();
    u32x4 raws[16];
#pragma unroll
    for (int rr = 0; rr < 16; ++rr) raws[rr] = *(const u32x4*)(PROJ + (size_t)(tc + wave * 16 + rr) * DIN + C_SV + 8 * lane);
#pragma unroll
    for (int rr = 0; rr < 16; ++rr) {
        const int j = wave * 16 + rr;
        const u32x4 raw = raws[rr];
        float v[8];
#pragma unroll
        for (int e = 0; e < 4; ++e) { v[2 * e] = __uint_as_float(raw[e] << 16); v[2 * e + 1] = __uint_as_float(raw[e] & 0xffff0000u); }
        float sm = 0.f;
#pragma unroll
        for (int e = 0; e < 8; ++e) sm += v[e];
        const float mean = wave_sum(sm, lane) * (1.0f / 512.0f); float q = 0.f;
#pragma unroll
        for (int e = 0; e < 8; ++e) { const float d = v[e] - mean; q += d * d; }
        const float rstd = rsqrtf(wave_sum(q, lane) * (1.0f / 512.0f) + EPS);
        if (lane == 0) { st[2 * j] = mean; st[2 * j + 1] = rstd; }
    }
    __syncthreads();
    {
        const int c = tid; const float g = lng[c], b = lnb[c];
        const bf16_t* src = PROJ + (size_t)tc * DIN + C_SV + c;
#pragma unroll 1
        for (int jb = 0; jb < 4; ++jb) {
            bf16_t rv[32];
#pragma unroll
            for (int e = 0; e < 32; ++e) rv[e] = src[(size_t)(32 * jb + e) * DIN];
#pragma unroll
            for (int jg = 0; jg < 4; ++jg) {
                float vn[8];
#pragma unroll
                for (int e = 0; e < 8; ++e) { const int j = 32 * jb + 8 * jg + e; vn[e] = (bf2f(rv[8 * jg + e]) - st[2 * j]) * st[2 * j + 1] * g + b; }
                u32x4 o; o.x = cvt_pk_bf16(vn[0], vn[1]); o.y = cvt_pk_bf16(vn[2], vn[3]); o.z = cvt_pk_bf16(vn[4], vn[5]); o.w = cvt_pk_bf16(vn[6], vn[7]);
                *(LAS u32x4*)(Vt + c * SG_P + 32 * jb + 8 * jg) = o;
            }
        }
    }
    __syncthreads();
    const int fr = lane & 15, fq = lane >> 4, irow = 16 * wave + fr, nks = (wave >> 1) + 1;
    f32x4 outv[8][4]; float ssq = 0.f;
    bf16x8 wa[2][4]; u32x2 ub[2][4]; float bs[2];
#define SGU_LOAD(buf, hh_) do { int hr = (hh_); asm volatile("" : "+s"(hr)); const bf16_t* swh = SW + ((size_t)(hr * 128 + irow) * 128 + 8 * fq); \
        _Pragma("unroll") for (int ks = 0; ks < 4; ++ks) wa[buf][ks] = *(const bf16x8*)(swh + 32 * ks); \
        const bf16_t* up = PROJ + (size_t)(tc + irow) * DIN + C_SU + hr * 64 + 4 * fq; \
        _Pragma("unroll") for (int nt = 0; nt < 4; ++nt) ub[buf][nt] = *(const u32x2*)(up + 16 * nt); \
        bs[buf] = sb[hr * 128 + irow]; } while (0)
    SGU_LOAD(0, 0);
#pragma unroll
    for (int h = 0; h < 8; ++h) {
        if (h < 7) SGU_LOAD((h + 1) & 1, h + 1);
        int hr = h; asm volatile("" : "+s"(hr));
        f32x4 acc[4];
#pragma unroll
        for (int nt = 0; nt < 4; ++nt) acc[nt] = (f32x4){0.f, 0.f, 0.f, 0.f};
        const LAS bf16_t* vth = Vt + (hr * 64 + fr) * SG_P + 8 * fq;
#pragma unroll
        for (int ks = 0; ks < 4; ++ks) if (ks < nks) {
#pragma unroll
            for (int nt = 0; nt < 4; ++nt) { const bf16x8 bf = *(const LAS bf16x8*)(vth + 16 * nt * SG_P + 32 * ks);
                acc[nt] = __builtin_amdgcn_mfma_f32_16x16x32_bf16(bf, wa[h & 1][ks], acc[nt], 0, 0, 0); }
        }
        const float bias = bs[h & 1];
#pragma unroll
        for (int nt = 0; nt < 4; ++nt) {
            const u32x2 ur = ub[h & 1][nt];
            f32x4 u; u[0] = __uint_as_float(ur.x << 16); u[1] = __uint_as_float(ur.x & 0xffff0000u); u[2] = __uint_as_float(ur.y << 16); u[3] = __uint_as_float(ur.y & 0xffff0000u);
            const f32x4 o = u * (acc[nt] + bias); outv[h][nt] = o; ssq += (o[0] * o[0] + o[1] * o[1]) + (o[2] * o[2] + o[3] * o[3]);
        }
    }
#undef SGU_LOAD
    ssq += shx(ssq, 16, lane); ssq += shx(ssq, 32, lane);
    const float r2 = rsqrtf(ssq * (1.0f / 512.0f) + EPS);
    int orow_r = tc + irow; asm volatile("" : "+v"(orow_r));
    bf16_t* orow = MIX + blk_off(orow_r, X_SGU + 4 * fq);
#pragma unroll
    for (int h = 0; h < 8; ++h)
#pragma unroll
        for (int nt = 0; nt < 4; ++nt) { const f32x4 o = outv[h][nt] * r2; u32x2 w; w.x = cvt_pk_bf16(o[0], o[1]); w.y = cvt_pk_bf16(o[2], o[3]); *(u32x2*)(orow + h * (256 * 64) + 16 * nt) = w; }
}

constexpr int AT_KP = 144, AT_VP = 520;
constexpr float LOG2E = 1.4426950408889634f;
__device__ __forceinline__ void attn_unit(LAS unsigned char* lds, int unit, const bf16_t* PROJ, bf16_t* MIX, float* AST, const float* gq, const float* gk, const float* sinks, int tid_in) {
    int tid = tid_in; asm volatile("" : "+v"(tid));
    const int lane = tid & 63, wave = __builtin_amdgcn_readfirstlane(tid >> 6);
    const int kvh = unit & 3, blk = (unit >> 2) & 15, b = unit >> 6;
    const int tb = b * SEQ + blk * 128, kb = tb - 128, jmin = blk == 0 ? 128 : 0;
    LAS unsigned char* Ks = lds; LAS unsigned char* Vt = lds + 256 * AT_KP; LAS float* ssx = (LAS float*)(lds + 256 * AT_KP + 64 * AT_VP);
    __syncthreads();
#pragma unroll
    for (int it = 0; it < 4; ++it) {
        const int idx = tid + 512 * it, kr = idx >> 3, c8 = idx & 7; const bool valid = kr >= jmin; const int row = valid ? kb + kr : tb;
        const u32x4 raw = *(const u32x4*)(PROJ + (size_t)row * DIN + C_K + kvh * 64 + c8 * 8);
        float v[8];
#pragma unroll
        for (int e = 0; e < 4; ++e) { v[2 * e] = __uint_as_float(raw[e] << 16); v[2 * e + 1] = __uint_as_float(raw[e] & 0xffff0000u); }
        float ss = 0.f;
#pragma unroll
        for (int e = 0; e < 8; ++e) ss += v[e] * v[e];
        ss += shx(ss, 1, lane); ss += shx(ss, 2, lane); ss += shx(ss, 4, lane);
        const float rk = valid ? rsqrtf(ss * (1.0f / 64.0f) + EPS) : 0.f;
        const f32x4 ga = *(const f32x4*)(gk + c8 * 8), gb = *(const f32x4*)(gk + c8 * 8 + 4);
        u32x4 o; o.x = cvt_pk_bf16(v[0] * rk * ga[0], v[1] * rk * ga[1]); o.y = cvt_pk_bf16(v[2] * rk * ga[2], v[3] * rk * ga[3]);
        o.z = cvt_pk_bf16(v[4] * rk * gb[0], v[5] * rk * gb[1]); o.w = cvt_pk_bf16(v[6] * rk * gb[2], v[7] * rk * gb[3]);
        *(LAS u32x4*)(Ks + kr * AT_KP + c8 * 16) = o;
    }
#pragma unroll
    for (int it = 0; it < 8; ++it) {
        const int idx = tid + 512 * it, d = idx & 63, kg = idx >> 6;
        unsigned short x[4];
#pragma unroll
        for (int e = 0; e < 4; ++e) { const int key = 4 * kg + e; const bool valid = key >= jmin; const int row = valid ? kb + key : tb;
            const bf16_t r = PROJ[(size_t)row * DIN + C_V + kvh * 64 + d]; x[e] = valid ? r : (bf16_t)0; }
        u32x2 o; o.x = (unsigned)x[0] | ((unsigned)x[1] << 16); o.y = (unsigned)x[2] | ((unsigned)x[3] << 16);
        *(LAS u32x2*)(Vt + d * AT_VP + kg * 8) = o;
    }
    __syncthreads();
    const int g = wave >> 1, half = wave & 1, h = kvh * 4 + g, q = lane & 31, hh = lane >> 5;
    const float sink2 = sinks[h] * LOG2E;
    u32x4 qraw[2][4];
#pragma unroll
    for (int qt = 0; qt < 2; ++qt) { const bf16_t* qp = PROJ + (size_t)(tb + half * 64 + qt * 32 + q) * DIN + C_Q + h * 64 + 8 * hh;
#pragma unroll
        for (int ks = 0; ks < 4; ++ks) qraw[qt][ks] = *(const u32x4*)(qp + 16 * ks); }
#pragma unroll
    for (int qt = 0; qt < 2; ++qt) {
        const int i0 = half * 64 + qt * 32, i = i0 + q, kt0 = i0 >> 5;
        bf16x8 qf[4];
        {
            float ss = 0.f;
#pragma unroll
            for (int ks = 0; ks < 4; ++ks) {
#pragma unroll
                for (int e = 0; e < 4; ++e) { const float a = __uint_as_float(qraw[qt][ks][e] << 16), c = __uint_as_float(qraw[qt][ks][e] & 0xffff0000u); ss += a * a + c * c; } }
            ss += shx(ss, 32, lane);
            const float rq = rsqrtf(ss * (1.0f / 64.0f) + EPS) * (0.125f * LOG2E);
#pragma unroll
            for (int ks = 0; ks < 4; ++ks) { const f32x4 ga = *(const f32x4*)(gq + 16 * ks + 8 * hh), gb = *(const f32x4*)(gq + 16 * ks + 8 * hh + 4);
                u32x4 o;
#pragma unroll
                for (int e = 0; e < 4; ++e) { const float a = __uint_as_float(qraw[qt][ks][e] << 16), c = __uint_as_float(qraw[qt][ks][e] & 0xffff0000u);
                    const float g0 = e < 2 ? ga[2 * e] : gb[2 * e - 4], g1 = e < 2 ? ga[2 * e + 1] : gb[2 * e - 3]; o[e] = cvt_pk_bf16(a * rq * g0, c * rq * g1); }
                qf[ks] = __builtin_bit_cast(bf16x8, o); }
        }
        f32x16 S[5];
        const LAS unsigned char* kp = Ks + (32 * kt0 + q) * AT_KP + 16 * hh;
#pragma unroll
        for (int kt = 0; kt < 5; ++kt) {
#pragma unroll
            for (int r = 0; r < 16; ++r) S[kt][r] = 0.f;
#pragma unroll
            for (int ks = 0; ks < 4; ++ks) { const bf16x8 kf = *(const LAS bf16x8*)(kp + kt * 32 * AT_KP + ks * 32);
                S[kt] = __builtin_amdgcn_mfma_f32_32x32x16_bf16(kf, qf[ks], S[kt], 0, 0, 0); }
        }
        float mx = -1e30f; const int qa = q - 4 * hh;
#pragma unroll
        for (int kt = 0; kt < 5; ++kt) { const bool tv = 32 * (kt0 + kt) >= jmin;
#pragma unroll
            for (int r = 0; r < 16; ++r) { const int kl = (r & 3) + 8 * (r >> 2);
                bool ok = tv; if (kt == 0) ok = ok && (kl > qa); if (kt == 4) ok = ok && (kl <= qa);
                const float sv = ok ? S[kt][r] : -1e30f; S[kt][r] = sv; mx = fmaxf(mx, sv); } }
        mx = fmaxf(mx, shx(mx, 32, lane)); mx = fmaxf(mx, sink2);
        float sum = 0.f;
#pragma unroll
        for (int kt = 0; kt < 5; ++kt)
#pragma unroll
            for (int r = 0; r < 16; ++r) { const float p = __builtin_amdgcn_exp2f(S[kt][r] - mx); S[kt][r] = p; sum += p; }
        sum += shx(sum, 32, lane);
        const float inv = __builtin_amdgcn_rcpf(sum + __builtin_amdgcn_exp2f(sink2 - mx));
        f32x16 O[2];
#pragma unroll
        for (int r = 0; r < 16; ++r) { O[0][r] = 0.f; O[1][r] = 0.f; }
        const LAS unsigned char* vp = Vt + q * AT_VP + (32 * kt0 + 4 * hh) * 2;
#pragma unroll
        for (int kt = 0; kt < 5; ++kt)
#pragma unroll
            for (int s2 = 0; s2 < 2; ++s2) {
                u32x4 pw; pw.x = cvt_pk_bf16(S[kt][8 * s2 + 0], S[kt][8 * s2 + 1]); pw.y = cvt_pk_bf16(S[kt][8 * s2 + 2], S[kt][8 * s2 + 3]);
                pw.z = cvt_pk_bf16(S[kt][8 * s2 + 4], S[kt][8 * s2 + 5]); pw.w = cvt_pk_bf16(S[kt][8 * s2 + 6], S[kt][8 * s2 + 7]);
                const bf16x8 pf = __builtin_bit_cast(bf16x8, pw);
#pragma unroll
                for (int dt = 0; dt < 2; ++dt) {
                    const u32x2 lo = *(const LAS u32x2*)(vp + dt * 32 * AT_VP + (32 * kt + 16 * s2) * 2), hi2 = *(const LAS u32x2*)(vp + dt * 32 * AT_VP + (32 * kt + 16 * s2 + 8) * 2);
                    u32x4 vw; vw.x = lo.x; vw.y = lo.y; vw.z = hi2.x; vw.w = hi2.y;
                    O[dt] = __builtin_amdgcn_mfma_f32_32x32x16_bf16(__builtin_bit_cast(bf16x8, vw), pf, O[dt], 0, 0, 0);
                }
            }
        float ssq = 0.f;
        bf16_t* op = MIX + blk_off(tb + i, X_ATT + h * 64 + 4 * hh);
#pragma unroll
        for (int dt = 0; dt < 2; ++dt)
#pragma unroll
            for (int g4 = 0; g4 < 4; ++g4) { float o0 = O[dt][4 * g4] * inv, o1 = O[dt][4 * g4 + 1] * inv, o2 = O[dt][4 * g4 + 2] * inv, o3 = O[dt][4 * g4 + 3] * inv;
                ssq += (o0 * o0 + o1 * o1) + (o2 * o2 + o3 * o3); u32x2 w; w.x = cvt_pk_bf16(o0, o1); w.y = cvt_pk_bf16(o2, o3); *(u32x2*)(op + 32 * dt + 8 * g4) = w; }
        ssq += shx(ssq, 32, lane);
        if (hh == 0) ssx[g * 128 + i] = ssq;
    }
    __syncthreads();
    if (tid < 128) AST[(size_t)(tb + tid) * 4 + kvh] = (ssx[tid] + ssx[128 + tid]) + (ssx[256 + tid] + ssx[384 + tid]);
}

constexpr int I_IN = (DM / 64) * (DIN / 64), I_OUT = (DM / 64) * (DM / 64), I_UP = (DM / 64) * (DFF / 64), I_DN = (DFF / 64) * (DM / 64), I_L = I_IN + I_OUT + I_UP + I_DN;
__device__ __forceinline__ void convert_range(const Args& args, unsigned char* ws, int l, int lo_item, int hi_item, int gwi, int ngw, LAS float* scr, int lane) {
    for (int it = lo_item + gwi; it < hi_item; it += ngw) {
        int r = it;
        if (r < I_IN) { p0_transpose_item(args.in[2] + (size_t)l * DM * DIN, args.in[1] + l * DM, DM, DIN, (bf16_t*)(ws + WS_WIN + l * SZ_WIN), scr, r, lane); continue; } r -= I_IN;
        if (r < I_OUT) { p0_transpose_item(args.in[15] + (size_t)l * DM * DM, args.in[14] + l * DM, DM, DM, (bf16_t*)(ws + WS_WOUT + l * SZ_WOUT), scr, r, lane); continue; } r -= I_OUT;
        if (r < I_UP) { p0_transpose_item(args.in[17] + (size_t)l * DM * DFF, args.in[16] + l * DM, DM, DFF, (bf16_t*)(ws + WS_WUP + l * SZ_WUP), scr, r, lane); continue; } r -= I_UP;
        p0_transpose_item(args.in[18] + (size_t)l * DFF * DM, nullptr, DFF, DM, (bf16_t*)(ws + WS_WDN + l * SZ_WDN), scr, r, lane);
    }
}

#define XB_TMO      128
#define XB_XCNT(j)  (256  + 64 * (j))
#define XB_XSUB(j)  (1280 + 64 * (j))
#define XB_XGEN(j)  (2304 + 64 * (j))
#define XB_TOP      3328
#define XB_TOPGEN   3392
#define XCD_BAR_WORDS 3456
#define XB_SPIN_CAP (1u << 18)
__device__ __forceinline__ unsigned xb_ld(unsigned* p)              { return __hip_atomic_load(p, __ATOMIC_RELAXED, __HIP_MEMORY_SCOPE_AGENT); }
__device__ __forceinline__ unsigned xb_add(unsigned* p, unsigned v) { return __hip_atomic_fetch_add(p, v, __ATOMIC_RELAXED, __HIP_MEMORY_SCOPE_AGENT); }
__device__ __forceinline__ unsigned xb_xcc_id() { return (unsigned)__builtin_amdgcn_s_getreg((3 << 11) | 20) & 0xFu; }
#define XB_SPIN(cond, bar) do { unsigned _sp = 0; while (cond) { __builtin_amdgcn_s_sleep(1); \
    if ((++_sp & 255u) == 0u) { if (xb_ld(&(bar)[XB_TMO])) break; if (_sp > XB_SPIN_CAP) { atomicAdd(&(bar)[XB_TMO], 1u); break; } } } } while (0)
struct XcdBarrier { unsigned* bar; unsigned x; volatile LAS unsigned* st; };
__device__ __forceinline__ XcdBarrier xcd_barrier_post(unsigned* bar, volatile LAS unsigned* st) {
    XcdBarrier b; b.bar = bar; b.x = xb_xcc_id(); b.st = st;
    if (threadIdx.x == 0) (void)xb_add(&bar[XB_XCNT(b.x)], 1u);
    return b;
}
__device__ __forceinline__ void xcd_barrier_complete(unsigned* bar, unsigned x, unsigned& nloc, unsigned& nx) {
    const unsigned G = gridDim.x * gridDim.y * gridDim.z;
    unsigned sum, cnt, mine, sp = 0u;
    for (;;) {
        sum = 0u; cnt = 0u; mine = 0u;
#pragma unroll
        for (unsigned j = 0; j < 16; ++j) { const unsigned c = xb_ld(&bar[XB_XCNT(j)]); sum += c; cnt += (c > 0u) ? 1u : 0u; mine = (j == x) ? c : mine; }
        if (sum == G) break;
        __builtin_amdgcn_s_sleep(1);
        if ((++sp & 255u) == 0u) { if (xb_ld(&bar[XB_TMO])) break; if (sp > XB_SPIN_CAP) { atomicAdd(&bar[XB_TMO], 1u); break; } }
    }
    nloc = mine > 0u ? mine : 1u; nx = cnt > 0u ? cnt : 1u;
}
__device__ __forceinline__ void xcd_barrier(const XcdBarrier& b, int wave_s) {
    asm volatile("s_waitcnt vmcnt(0)" ::: "memory");
    __syncthreads();
    if (wave_s == 0 && lane_id() == 0) {
        unsigned* bar = b.bar;
        __builtin_amdgcn_s_waitcnt(0);
        unsigned nloc = b.st[0], nx = b.st[1];
        if (nloc == 0u) { xcd_barrier_complete(bar, b.x, nloc, nx); b.st[0] = nloc; b.st[1] = nx; }
        const unsigned old = xb_add(&bar[XB_XSUB(b.x)], 1u);
        const unsigned gen = old / nloc;
        if (old + 1u == (gen + 1u) * nloc) {
            __builtin_amdgcn_fence(__ATOMIC_RELEASE, "agent");
            asm volatile("s_waitcnt vmcnt(0)" ::: "memory");
            const unsigned og = xb_add(&bar[XB_TOP], 1u);
            const unsigned tg = og / nx;
            if (og + 1u == (tg + 1u) * nx) xb_add(&bar[XB_TOPGEN], 1u);
            else XB_SPIN(xb_ld(&bar[XB_TOPGEN]) == tg, bar);
            __builtin_amdgcn_fence(__ATOMIC_ACQUIRE, "agent");
            xb_add(&bar[XB_XGEN(b.x)], 1u);
            asm volatile("s_waitcnt vmcnt(0)" ::: "memory");
        } else {
            XB_SPIN(xb_ld(&bar[XB_XGEN(b.x)]) == gen, bar);
            __builtin_amdgcn_fence(__ATOMIC_ACQUIRE, "agent");
            asm volatile("s_waitcnt vmcnt(0)" ::: "memory");
        }
    }
    __syncthreads();
}

__global__ void __launch_bounds__(NTHREADS, 2) fwd(Args args) {
    extern __shared__ __attribute__((aligned(16))) unsigned char lds_raw[];
    LAS unsigned char* lds = (LAS unsigned char*)lds_raw;
    const int tid = threadIdx.x, lane = tid & 63, wave = __builtin_amdgcn_readfirstlane(tid >> 6);
    const int G = gridDim.x, bx = blockIdx.x;
    const int gw = bx * NWAVES + wave, NGW = G * NWAVES;
    unsigned char* ws = args.ws;
    bf16_t* XB = (bf16_t*)(ws + WS_XB); bf16_t* PROJ = (bf16_t*)(ws + WS_PROJ); bf16_t* MIX = (bf16_t*)(ws + WS_MIX); bf16_t* HB = (bf16_t*)(ws + WS_H);
    float* RSA = (float*)(ws + WS_RSA); float* RSB = (float*)(ws + WS_RSB); float* AST = (float*)(ws + WS_AST);
    const int lo = args.ph_lo, hi = args.ph_hi;
    const bool split = (G == 256) && (DEPTH == 2);
#if MK_ONE_LAUNCH
    cg::grid_group grid = cg::this_grid();
    volatile LAS unsigned* MISC = (volatile LAS unsigned*)(lds + LDS_BYTES - 64);
    if (tid < 16) MISC[tid] = 0u;
    __syncthreads();
    const XcdBarrier xbar = xcd_barrier_post((unsigned*)(ws + WS_BAR), MISC);
    if (hi > 1000) grid.sync();
#define SEAM(k) do { if ((k) + 1 < hi) xcd_barrier(xbar, wave); } while (0)
#else
#define SEAM(k) do { } while (0)
#endif
#define IN(k) (lo <= (k) && (k) < hi)

    if (IN(0)) {
        LAS float* scr = (LAS float*)(lds + wave * 16640);
        convert_range(args, ws, 0, 0, I_L, gw, NGW, scr, lane);
        if (!split) convert_range(args, ws, 1, 0, I_L, gw, NGW, scr, lane);
        for (int i = bx * NTHREADS + tid; i < DEPTH * 8 * 128 * 128; i += G * NTHREADS) {
            const int ii = (i >> 7) & 127, jj = i & 127; ((bf16_t*)(ws + WS_SGUW))[i] = jj <= ii ? f2bf(args.in[12][i]) : (bf16_t)0; }
        const float* x = args.in[0];
        for (int m = 2 * gw; m < M; m += 2 * NGW) {
            const f32x4* xr = (const f32x4*)(x + (size_t)m * DM) + lane; f32x4 v[16];
#pragma unroll
            for (int j = 0; j < 16; ++j) v[j] = xr[64 * j];
            float ss0 = 0.f, ss1 = 0.f;
#pragma unroll
            for (int j = 0; j < 16; ++j) { const float q = (v[j][0] * v[j][0] + v[j][1] * v[j][1]) + (v[j][2] * v[j][2] + v[j][3] * v[j][3]); if (j < 8) ss0 += q; else ss1 += q;
                u32x2 w; w.x = cvt_pk_bf16(v[j][0], v[j][1]); w.y = cvt_pk_bf16(v[j][2], v[j][3]); *(u32x2*)(XB + blk_off(m + (j >> 3), 4 * lane + 256 * (j & 7))) = w; }
            ss0 = wave_sum(ss0, lane); ss1 = wave_sum(ss1, lane); if (lane == 0) { RSA[m] = ss0; RSA[m + 1] = ss1; }
        }
        SEAM(0);
    }
    for (int l = 0; l < DEPTH; ++l) {
        const int pb = 1 + 5 * l;
        if (IN(pb)) {
            pg8::Gemm g{XB, (const bf16_t*)(ws + WS_WIN + l * SZ_WIN), M, DIN, DM}; pg8::StaticOrder S; S.init(M, DIN, G, bx);
            pg8::EpiScaleBf16<0> E{PROJ, DIN, RSA + (size_t)l * M, 1.0f / DM};
            pg8::gemm_phase<pg8::EpiScaleBf16<0>, true, true, true>(lds, g, S, E, wave);
            if (split && bx >= 128) {
                int t_ = wave * 64 + lane_id(); asm volatile("" : "+v"(t_));
                LAS float* scr = (LAS float*)(lds + wave * 16640);
                if (l == 0) convert_range(args, ws, 1, 0, I_IN + I_OUT + I_UP, (bx - 128) * NWAVES + wave, 128 * NWAVES, scr, t_ & 63);
                else convert_range(args, ws, 1, I_IN + I_OUT + I_UP, I_L, (bx - 128) * NWAVES + wave, 128 * NWAVES, scr, t_ & 63);
            }
            SEAM(pb);
        }
        if (IN(pb + 1)) {
            int t_ = wave * 64 + lane_id(); asm volatile("" : "+v"(t_));
            for (int u = bx; u < 512; u += G) attn_unit(lds, u, PROJ, MIX, AST, args.in[3] + l * 64, args.in[4] + l * 64, args.in[5] + l * 16, t_);
            for (int u = bx; u < 256; u += G) {
                if (u < 128) sgu_unit(lds, u, PROJ, MIX, (const bf16_t*)(ws + WS_SGUW + l * SZ_SGUW), args.in[10] + l * 512, args.in[11] + l * 512, args.in[13] + l * 8 * 128, t_);
                else { conv_unit(lds, 2 * (u - 128), PROJ, MIX, args.in[6] + l * 31 * 512, args.in[7] + l * 512, args.in[8] + l * 512, args.in[9] + l * 512, t_);
                       conv_unit(lds, 2 * (u - 128) + 1, PROJ, MIX, args.in[6] + l * 31 * 512, args.in[7] + l * 512, args.in[8] + l * 512, args.in[9] + l * 512, t_); }
            }
            SEAM(pb + 1);
        }
        if (IN(pb + 2)) {
            pg8::Gemm g{MIX, (const bf16_t*)(ws + WS_WOUT + l * SZ_WOUT), M, DM, DM}; pg8::StaticOrder S; S.init(M, DM, G, bx);
            pg8::EpiRes<16, false> E{XB, nullptr, RSB + (size_t)l * M, AST, DM};
            pg8::gemm_phase<pg8::EpiRes<16, false>, true, true, true>(lds, g, S, E, wave);
            SEAM(pb + 2);
        }
        if (IN(pb + 3)) {
            pg8::Gemm g{XB, (const bf16_t*)(ws + WS_WUP + l * SZ_WUP), M, DFF, DM}; pg8::StaticOrder S; S.init(M, DFF, G, bx, 2);
            pg8::EpiScaleBf16<1, true> E{HB, DFF, RSB + (size_t)l * M, 1.0f / DM};
            pg8::gemm_phase<pg8::EpiScaleBf16<1, true>, true, true, true>(lds, g, S, E, wave);
            SEAM(pb + 3);
        }
        if (IN(pb + 4)) {
            pg8::Gemm g{HB, (const bf16_t*)(ws + WS_WDN + l * SZ_WDN), M, DM, DFF}; pg8::StaticOrder S; S.init(M, DM, G, bx, 1);
            if (l == DEPTH - 1) { pg8::EpiRes<0, true> E{XB, args.out, nullptr, nullptr, DM}; pg8::gemm_phase<pg8::EpiRes<0, true>, true, true, true>(lds, g, S, E, wave); }
            else { pg8::EpiRes<0, false> E{XB, nullptr, RSA + (size_t)(l + 1) * M, nullptr, DM}; pg8::gemm_phase<pg8::EpiRes<0, false>, true, true, true>(lds, g, S, E, wave); }
            SEAM(pb + 4);
        }
    }
#undef IN
#undef SEAM
}

constexpr int NPHASES = 1 + 5 * DEPTH;

extern "C" void kernel_launch(void* const* d_in, const int* in_sizes, int n_in, void* d_out, int out_size, void* d_ws, size_t ws_size, hipStream_t stream) {
    static int grid = 0;
    if (grid == 0) {
        if (n_in != 19 || in_sizes[0] != M * DM || out_size != M * DM || ws_size < WS_END) {
            fprintf(stderr, "kernel_launch: unexpected shapes (n_in %d, in0 %d, out %d, ws %zu need %zu); nothing launched\n", n_in, n_in > 0 ? in_sizes[0] : -1, out_size, ws_size, (size_t)WS_END); grid = -1; return; }
        int dev = 0, cus = 0, per_cu = 0;
        (void)hipGetDevice(&dev); (void)hipDeviceGetAttribute(&cus, hipDeviceAttributeMultiprocessorCount, dev);
        if (hipFuncSetAttribute((const void*)fwd, hipFuncAttributeMaxDynamicSharedMemorySize, LDS_BYTES) != hipSuccess) { fprintf(stderr, "kernel_launch: hipFuncSetAttribute failed\n"); grid = -1; return; }
        (void)hipOccupancyMaxActiveBlocksPerMultiprocessor(&per_cu, (const void*)fwd, NTHREADS, LDS_BYTES);
        if (per_cu < 1) fprintf(stderr, "kernel_launch: occupancy query says %d blocks per CU\n", per_cu);
        (void)hipGetLastError();
        grid = cus > 0 ? cus : 256;
    }
    if (grid < 0) return;
    (void)hipMemsetAsync((unsigned char*)d_ws + WS_BAR, 0, 16384 + (size_t)(2 * DEPTH) * M * 4, stream);
    Args a{};
    for (int i = 0; i < 19; ++i) a.in[i] = (const float*)d_in[i];
    a.out = (float*)d_out; a.ws = (unsigned char*)d_ws;
#if MK_ONE_LAUNCH
    a.ph_lo = 0; a.ph_hi = NPHASES;
    void* kargs[] = {&a};
    hipError_t e = hipLaunchCooperativeKernel((const void*)fwd, dim3(grid), dim3(NTHREADS), kargs, LDS_BYTES, stream);
    if (e != hipSuccess) fprintf(stderr, "cooperative launch failed: %s (grid %d)\n", hipGetErrorString(e), grid);
#else
    for (int p = 0; p < NPHASES; ++p) {
        a.ph_lo = p; a.ph_hi = p + 1;
        hipLaunchKernelGGL(fwd, dim3(grid), dim3(NTHREADS), LDS_BYTES, stream, a);
    }
#endif
}
```

```cpp
#include <hip/hip_runtime.h>
#include <hip/hip_cooperative_groups.h>
#include <cstdio>
#include <cstdint>
namespace cg = cooperative_groups;

#ifndef MK_ONE_LAUNCH
#define MK_ONE_LAUNCH 1
#endif

constexpr int DM = 2048, SEQ = 2048, NB = 8, M = NB * SEQ, DIN = 3584, DFF = 8192, DEPTH = 2;
constexpr int C_Q = 0, C_K = 1024, C_V = 1280, C_CA = 1536, C_CG = 2048, C_SU = 2560, C_SV = 3072;
constexpr int X_ATT = 0, X_CONV = 1024, X_SGU = 1536;
constexpr float EPS = 1e-6f;

#define LAS __attribute__((address_space(3)))
typedef unsigned short bf16_t;
typedef short bf16x8 __attribute__((ext_vector_type(8)));
typedef float f32x4 __attribute__((ext_vector_type(4)));
typedef unsigned u32x4 __attribute__((ext_vector_type(4)));
typedef unsigned u32x2 __attribute__((ext_vector_type(2)));

__device__ __forceinline__ unsigned cvt_pk_bf16(float lo, float hi) { unsigned r; asm volatile("v_cvt_pk_bf16_f32 %0, %1, %2" : "=v"(r) : "v"(lo), "v"(hi)); return r; }
__device__ __forceinline__ float bf2f(bf16_t b) { return __uint_as_float(((unsigned)b) << 16); }
__device__ __forceinline__ bf16_t f2bf(float f) { return (bf16_t)(cvt_pk_bf16(f, 0.f) & 0xffffu); }
__device__ __forceinline__ int lane_id() { int x; asm volatile("v_mbcnt_lo_u32_b32 %0, -1, 0\n\tv_mbcnt_hi_u32_b32 %0, -1, %0" : "=v"(x)); return x; }
__device__ __forceinline__ float shx(float v, int o, int lane) { return __int_as_float(__builtin_amdgcn_ds_bpermute((lane ^ o) << 2, __float_as_int(v))); }
__device__ __forceinline__ float shl(float v, int src) { return __int_as_float(__builtin_amdgcn_ds_bpermute(src << 2, __float_as_int(v))); }
__device__ __forceinline__ float wave_sum(float v, int lane) {
#pragma unroll
    for (int o = 1; o < 64; o <<= 1) v += shx(v, o, lane);
    return v;
}
__device__ __forceinline__ float wave_max(float v, int lane) {
#pragma unroll
    for (int o = 1; o < 64; o <<= 1) v = fmaxf(v, shx(v, o, lane));
    return v;
}

__device__ __forceinline__ size_t blk_off(int row, int col) { return (((size_t)(row >> 8) * (DM / 64) + (col >> 6)) * 256 + (row & 255)) * 64 + (col & 63); }

__device__ __forceinline__ ptrdiff_t proj_off(int row, int col) { return (((ptrdiff_t)(row >> 8) * (DIN / 64) + (col >> 6)) * 256 + (row & 255)) * 64 + (col & 63); }

namespace pg8 {
constexpr int BM = 256, BK = 64, HALF = 128, HTB = HALF * BK * 2, STAGE_BYTES = 8 * HTB, NXCD = 8, WGM = 8;
__host__ __device__ __forceinline__ int lds_byte(int r, int c) { const int st = (r >> 4) * 2 + (c >> 5), rr = r & 15, cc = c & 31, ob = rr * 64 + cc * 2; return st * 1024 + (ob ^ (((ob >> 9) & 1) << 5)); }
__host__ __device__ __forceinline__ void stage_rc(int b, int& R, int& C) { const int st = b / 1024, sb = b % 1024, swz = sb ^ (((sb >> 9) & 1) << 5); R = (st >> 1) * 16 + swz / 64; C = (st & 1) * 32 + (swz % 64) / 2; }
__host__ __device__ __forceinline__ int perm32(int rho) { const int n = rho >> 4, i = rho & 15; return 8 * (i >> 2) + 4 * n + (i & 3); }

struct Unit { int pm, pn; };
struct Gemm { const bf16_t* A; const bf16_t* Bt; int M, N, K; };

struct StaticOrder {
    int nM, nN, nwg, G, c, pnfast;
    __host__ __device__ void init(int M_, int N_, int G_, int c_, int pnfast_ = 0) { nM = M_ / BM; nN = N_ / BM; nwg = nM * nN; G = G_; c = c_; pnfast = pnfast_; }
    __host__ __device__ bool next(int i, Unit& u) const {
        const long L = (long)i * G + c; if (L >= nwg) return false;
        int wgid = (int)L; { const int q = nwg / NXCD, r = nwg % NXCD, xcd = wgid % NXCD, off = wgid / NXCD; wgid = (xcd < r ? xcd * (q + 1) : r * (q + 1) + (xcd - r) * q) + off; }
        const int nig = WGM * nN, gid = wgid / nig, fm = gid * WGM, gsz = (nM - fm) < WGM ? (nM - fm) : WGM;
        if (pnfast == 2) { const int j = wgid % nig, rnd = j >> 5, k = j & 31; u.pn = 8 * (rnd >> 1) + (k & 7); u.pm = fm + 4 * (rnd & 1) + (k >> 3); }
        else if (pnfast) { u.pn = (wgid % nig) % nN; u.pm = fm + (wgid % nig) / nN; } else { u.pm = fm + ((wgid % nig) % gsz); u.pn = (wgid % nig) / gsz; }
        return true;
    }
};

template <int ACT, bool OBLK = false> struct EpiScaleBf16 {
    static constexpr bool PERM = true; static constexpr int MID_T = 0;
    bf16_t* O; int ldc; const float* rowss; float inv_n;
    __device__ __forceinline__ void mid(f32x4 (&)[2][2][4][2], const Unit&, int, int) const {}
    __device__ __forceinline__ void prefetch(float (&pre)[8], const Unit& u, int wr, int fr) const {
        const float* p = rowss + u.pm * BM + wr * 64 + fr;
#pragma unroll
        for (int ai = 0; ai < 2; ++ai)
#pragma unroll
            for (int m = 0; m < 4; ++m) pre[ai * 4 + m] = p[ai * HALF + m * 16];
    }
    __device__ __forceinline__ void operator()(const f32x4 (&acc)[2][2][4][2], const float (&pre)[8], const Unit& u, int wr, int wc, int fr, int fq) const {
        const int row0 = u.pm * BM + wr * 64 + fr; const int col0 = u.pn * BM + wc * 32 + 8 * fq;
#pragma unroll
        for (int ai = 0; ai < 2; ++ai)
#pragma unroll
            for (int m = 0; m < 4; ++m) { const int row = row0 + ai * HALF + m * 16; const float rs = rsqrtf(pre[ai * 4 + m] * inv_n + EPS);
                bf16_t* rowp = OBLK ? O + (((size_t)u.pm * (ldc >> 6) + (col0 >> 6)) * 256 + (row & 255)) * 64 + (col0 & 63) : O + (size_t)row * ldc + col0;
#pragma unroll
                for (int bj = 0; bj < 2; ++bj) { f32x4 v0 = acc[ai][bj][m][0] * rs, v1 = acc[ai][bj][m][1] * rs;
                    if (ACT == 1) {
#pragma unroll
                        for (int e = 0; e < 4; ++e) { float a = fmaxf(v0[e], 0.f), b = fmaxf(v1[e], 0.f); v0[e] = a * a; v1[e] = b * b; } }
                    u32x4 w; w.x = cvt_pk_bf16(v0[0], v0[1]); w.y = cvt_pk_bf16(v0[2], v0[3]); w.z = cvt_pk_bf16(v1[0], v1[1]); w.w = cvt_pk_bf16(v1[2], v1[3]);
                    *(u32x4*)(rowp + (OBLK ? bj * (HALF / 64) * 256 * 64 : bj * HALF)) = w; } }
    }
};
template <int MIDT, bool FINAL> struct EpiRes {
    static constexpr bool PERM = true; static constexpr int MID_T = MIDT;
    bf16_t* xb; float* outf; float* rowss_out; const float* astat; int ldc;
    __device__ __forceinline__ void mid(f32x4 (&acc)[2][2][4][2], const Unit& u, int wr, int fr) const {
        const int row0 = u.pm * BM + wr * 64 + fr;
#pragma unroll
        for (int ai = 0; ai < 2; ++ai)
#pragma unroll
            for (int m = 0; m < 4; ++m) { const int row = row0 + ai * HALF + m * 16; const f32x4 s = *(const f32x4*)(astat + (size_t)row * 4);
                const float r1 = rsqrtf(((s[0] + s[1]) + (s[2] + s[3])) * (1.0f / 1024.0f) + EPS);
#pragma unroll
                for (int bj = 0; bj < 2; ++bj)
#pragma unroll
                    for (int n = 0; n < 2; ++n) acc[ai][bj][m][n] = acc[ai][bj][m][n] * r1;
                asm volatile("" ::: "memory"); }
    }
    __device__ __forceinline__ void prefetch(float (&)[8], const Unit&, int, int) const {}
    __device__ __forceinline__ void operator()(const f32x4 (&acc)[2][2][4][2], const float (&)[8], const Unit& u, int wr, int wc, int fr, int fq) const {
        const int row0 = u.pm * BM + wr * 64 + fr; const int col0 = u.pn * BM + wc * 32 + 8 * fq, lane = fr + 16 * fq;
        u32x4 bv[2][4][2];
#pragma unroll
        for (int ai = 0; ai < 2; ++ai)
#pragma unroll
            for (int m = 0; m < 4; ++m) { const bf16_t* rp = xb + blk_off(row0 + ai * HALF + m * 16, col0);
#pragma unroll
                for (int bj = 0; bj < 2; ++bj) bv[ai][m][bj] = *(const u32x4*)(rp + bj * (2 * 256 * 64)); }
#pragma unroll
        for (int ai = 0; ai < 2; ++ai)
#pragma unroll
            for (int m = 0; m < 4; ++m) { const int row = row0 + ai * HALF + m * 16; const size_t off = (size_t)row * ldc + col0; float ss = 0.f;
#pragma unroll
                for (int bj = 0; bj < 2; ++bj) { const u32x4 b = bv[ai][m][bj]; f32x4 o0, o1;
                    o0[0] = __uint_as_float(b.x << 16); o0[1] = __uint_as_float(b.x & 0xffff0000u); o0[2] = __uint_as_float(b.y << 16); o0[3] = __uint_as_float(b.y & 0xffff0000u);
                    o1[0] = __uint_as_float(b.z << 16); o1[1] = __uint_as_float(b.z & 0xffff0000u); o1[2] = __uint_as_float(b.w << 16); o1[3] = __uint_as_float(b.w & 0xffff0000u);
                    o0 = o0 + acc[ai][bj][m][0]; o1 = o1 + acc[ai][bj][m][1];
                    if (FINAL) { *(f32x4*)(outf + off + bj * HALF) = o0; *(f32x4*)(outf + off + bj * HALF + 4) = o1; }
                    else { u32x4 w; w.x = cvt_pk_bf16(o0[0], o0[1]); w.y = cvt_pk_bf16(o0[2], o0[3]); w.z = cvt_pk_bf16(o1[0], o1[1]); w.w = cvt_pk_bf16(o1[2], o1[3]);
                        *(u32x4*)(xb + blk_off(row, col0) + bj * (2 * 256 * 64)) = w; }
                    ss += ((o0[0] * o0[0] + o0[1] * o0[1]) + (o0[2] * o0[2] + o0[3] * o0[3])) + ((o1[0] * o1[0] + o1[1] * o1[1]) + (o1[2] * o1[2] + o1[3] * o1[3])); }
                if (!FINAL) { if (rowss_out) { ss += shx(ss, 16, lane); ss += shx(ss, 32, lane); if (fq == 0) atomicAdd(rowss_out + row, ss); } } }
    }
};

template <class Epi, bool ALIGN_EPI, bool ABLK = false, bool BBLK = false>
__device__ __forceinline__ void gemm_phase(LAS unsigned char* lds, const Gemm g, const StaticOrder& S, const Epi& E, int wave_s) {
    int tid = wave_s * 64 + lane_id(); asm volatile("" : "+v"(tid));
    const int wid = __builtin_amdgcn_readfirstlane(tid >> 6), lane = tid & 63, wr = wid >> 2, wc = wid & 3, fr = lane & 15, fq = lane >> 4;
    const int K = g.K, nt = K / BK;
    unsigned voffA, voffB;
    const int pitchA = ABLK ? 64 : K, pitchB = BBLK ? 64 : K;
    { int R, C; stage_rc(tid * 16, R, C); const int Rb = Epi::PERM ? ((R & ~31) + perm32(R & 31)) : R; voffA = (unsigned)(R * pitchA + C) * 2u; voffB = (unsigned)(Rb * pitchB + C) * 2u; }
    const size_t r64A = (size_t)64 * pitchA * 2, r64B = (size_t)64 * pitchB * 2;
    const size_t kstepA = ABLK ? (size_t)(BM * BK * 2) : (size_t)(BK * 2), kstepB = BBLK ? (size_t)(BM * BK * 2) : (size_t)(BK * 2);
    const size_t hstepA = (size_t)HALF * pitchA * 2, hstepB = (size_t)HALF * pitchB * 2;
    const size_t tstep = (size_t)BM * K * 2;
    const unsigned ldsw = (unsigned)wid * 1024u;
    const int aoff = lds_byte(wr * 64 + fr, fq * 8), boff = lds_byte(wc * 32 + fr, fq * 8);
#define PG8_SA(b, h) (((b) * 2 + (h)) * HTB)
#define PG8_SB(b, h) ((4 + (b) * 2 + (h)) * HTB)
#define PG8_STAGE(bufoff, gbase, voff, r64) do { _Pragma("unroll") for (int _i = 0; _i < 2; ++_i) \
        __builtin_amdgcn_global_load_lds((const unsigned*)((const char*)(gbase) + _i * r64 + (voff)), (LAS unsigned*)(lds + (bufoff) + ldsw + _i * 8192), 16, 0, 0); } while (0)
#define PG8_LDA(dst, b, h) do { _Pragma("unroll") for (int m = 0; m < 4; ++m) _Pragma("unroll") for (int k = 0; k < 2; ++k) dst[m][k] = *(const LAS bf16x8*)(lds + PG8_SA(b, h) + aoff + m * 2048 + k * 1024); } while (0)
#define PG8_LDB(dst, b, h) do { _Pragma("unroll") for (int n = 0; n < 2; ++n) _Pragma("unroll") for (int k = 0; k < 2; ++k) dst[n][k] = *(const LAS bf16x8*)(lds + PG8_SB(b, h) + boff + n * 2048 + k * 1024); } while (0)
#define PG8_MMA(ai, bj, At, Bt) do { __builtin_amdgcn_s_setprio(1); _Pragma("unroll") for (int m = 0; m < 4; ++m) _Pragma("unroll") for (int n = 0; n < 2; ++n) _Pragma("unroll") for (int k = 0; k < 2; ++k) \
        acc[ai][bj][m][n] = __builtin_amdgcn_mfma_f32_16x16x32_bf16(Bt[n][k], At[m][k], acc[ai][bj][m][n], 0, 0, 0); __builtin_amdgcn_s_setprio(0); } while (0)
#define PG8_WAIT_V(n) asm volatile("s_waitcnt vmcnt(" #n ")" ::: "memory")
#define PG8_WAIT_L(n) asm volatile("s_waitcnt lgkmcnt(" #n ")" ::: "memory")
#define PG8_BAR __builtin_amdgcn_s_barrier()
#define PG8_SCHED __builtin_amdgcn_sched_barrier(0)
    Unit cur, nxt; int ui = 0;
    if (!S.next(0, cur)) return;
    f32x4 acc[2][2][4][2];
#pragma unroll
    for (int a = 0; a < 2; ++a)
#pragma unroll
        for (int b = 0; b < 2; ++b)
#pragma unroll
            for (int m = 0; m < 4; ++m)
#pragma unroll
                for (int n = 0; n < 2; ++n) acc[a][b][m][n] = (f32x4){0.f, 0.f, 0.f, 0.f};
    bf16x8 At[4][2], B0[2][2], B1[2][2];
    float pre[8];
#pragma unroll
    for (int k = 0; k < 8; ++k) pre[k] = 0.f;
    const char* cA = (const char*)g.A + (size_t)cur.pm * tstep; const char* cB = (const char*)g.Bt + (size_t)cur.pn * tstep;
    PG8_STAGE(PG8_SB(0, 0), cB, voffB, r64B); PG8_STAGE(PG8_SB(0, 1), cB + hstepB, voffB, r64B); PG8_STAGE(PG8_SA(0, 0), cA, voffA, r64A); PG8_STAGE(PG8_SA(0, 1), cA + hstepA, voffA, r64A);
    PG8_STAGE(PG8_SB(1, 0), cB + kstepB, voffB, r64B); PG8_STAGE(PG8_SA(1, 0), cA + kstepA, voffA, r64A); PG8_STAGE(PG8_SB(1, 1), cB + hstepB + kstepB, voffB, r64B);
    if (wr == 1) PG8_BAR;
    PG8_WAIT_V(8); PG8_BAR;
    PG8_WAIT_V(6); PG8_BAR;
    for (;;) {
        const bool has_next = S.next(ui + 1, nxt);
        const char* nA = has_next ? (const char*)g.A + (size_t)nxt.pm * tstep : cA; const char* nB = has_next ? (const char*)g.Bt + (size_t)nxt.pn * tstep : cB;
        for (int t = 0; t < nt; t += 2) {
            if constexpr (Epi::MID_T > 0) { if (t == Epi::MID_T) E.mid(acc, cur, wr, fr); }
            const bool last = (t == nt - 2);
            if (last) E.prefetch(pre, cur, wr, fr);
            const char* a1 = cA + (size_t)(t + 1) * kstepA;
            const char* a2 = last ? nA : cA + (size_t)(t + 2) * kstepA; const char* b2 = last ? nB : cB + (size_t)(t + 2) * kstepB;
            const char* a3 = a2 + kstepA; const char* b3 = b2 + kstepB;
            PG8_LDB(B0, 0, 0); PG8_LDB(B1, 0, 1); PG8_SCHED; PG8_LDA(At, 0, 0); PG8_STAGE(PG8_SA(1, 1), a1 + hstepA, voffA, r64A);
            PG8_WAIT_V(8); PG8_WAIT_L(0); PG8_BAR; PG8_MMA(0, 0, At, B0); PG8_MMA(0, 1, At, B1); PG8_BAR; PG8_SCHED;
            PG8_LDA(At, 0, 1); PG8_STAGE(PG8_SB(0, 0), b2, voffB, r64B); PG8_STAGE(PG8_SB(0, 1), b2 + hstepB, voffB, r64B); PG8_STAGE(PG8_SA(0, 0), a2, voffA, r64A);
            PG8_WAIT_V(8); PG8_WAIT_L(0); PG8_BAR; PG8_MMA(1, 0, At, B0); PG8_MMA(1, 1, At, B1); PG8_BAR; PG8_SCHED;
            PG8_LDB(B0, 1, 0); PG8_LDB(B1, 1, 1); PG8_SCHED; PG8_LDA(At, 1, 0); PG8_STAGE(PG8_SA(0, 1), a2 + hstepA, voffA, r64A);
            PG8_WAIT_V(8); PG8_WAIT_L(0); PG8_BAR; PG8_MMA(0, 0, At, B0); PG8_MMA(0, 1, At, B1); PG8_BAR; PG8_SCHED;
            PG8_LDA(At, 1, 1); PG8_STAGE(PG8_SB(1, 0), b3, voffB, r64B); PG8_STAGE(PG8_SB(1, 1), b3 + hstepB, voffB, r64B); PG8_STAGE(PG8_SA(1, 0), a3, voffA, r64A);
            PG8_WAIT_V(8); PG8_WAIT_L(0); PG8_BAR; PG8_MMA(1, 0, At, B0); PG8_MMA(1, 1, At, B1); PG8_BAR; PG8_SCHED;
        }
        if constexpr (ALIGN_EPI) { if (wr == 0) PG8_BAR; }
        E(acc, pre, cur, wr, wc, fr, fq);
        if (!has_next) break;
#pragma unroll
        for (int a = 0; a < 2; ++a)
#pragma unroll
            for (int b = 0; b < 2; ++b)
#pragma unroll
                for (int m = 0; m < 4; ++m)
#pragma unroll
                    for (int n = 0; n < 2; ++n) acc[a][b][m][n] = (f32x4){0.f, 0.f, 0.f, 0.f};
        cur = nxt; cA = nA; cB = nB; ++ui;
        if constexpr (ALIGN_EPI) { if (wr == 1) PG8_BAR; }
    }
    PG8_WAIT_V(0);
    if constexpr (!ALIGN_EPI) { if (wr == 0) PG8_BAR; }
    PG8_BAR;
#undef PG8_SA
#undef PG8_SB
#undef PG8_STAGE
#undef PG8_LDA
#undef PG8_LDB
#undef PG8_MMA
#undef PG8_WAIT_V
#undef PG8_WAIT_L
#undef PG8_BAR
#undef PG8_SCHED
}
}

constexpr int NWAVES = 8, NTHREADS = 512;
constexpr int RING_BYTES = 131072, LDS_BYTES = 147456;
constexpr size_t MiB = 1u << 20;
constexpr size_t SZ_WIN = (size_t)DIN * DM * 2, SZ_WOUT = (size_t)DM * DM * 2, SZ_WUP = (size_t)DFF * DM * 2, SZ_WDN = (size_t)DM * DFF * 2, SZ_SGUW = (size_t)8 * 128 * 128 * 2;
constexpr size_t WS_WIN = 0;
constexpr size_t WS_WOUT = WS_WIN + DEPTH * SZ_WIN;
constexpr size_t WS_WUP = WS_WOUT + DEPTH * SZ_WOUT;
constexpr size_t WS_WDN = WS_WUP + DEPTH * SZ_WUP;
constexpr size_t WS_SGUW = WS_WDN + DEPTH * SZ_WDN;
constexpr size_t WS_BAR = WS_SGUW + DEPTH * SZ_SGUW;
constexpr size_t WS_RSA = WS_BAR + 16384;
constexpr size_t WS_RSB = WS_RSA + (size_t)DEPTH * M * 4;
constexpr size_t WS_AST = WS_RSB + (size_t)DEPTH * M * 4;
constexpr size_t WS_XB = WS_AST + (size_t)M * 16;
constexpr size_t WS_R = WS_XB + (size_t)M * DM * 2;
constexpr size_t WS_PROJ = WS_R, WS_MIX = WS_R + (size_t)M * DIN * 2, WS_H = WS_R;
constexpr size_t WS_END = WS_R + (size_t)M * DFF * 2;
static_assert(WS_XB % 256 == 0 && WS_R % 256 == 0 && WS_MIX % 256 == 0, "alignment");

struct Args { const float* in[19]; float* out; unsigned char* ws; int ph_lo, ph_hi; };

__device__ __forceinline__ void p0_transpose_item(const float* W, const float* gain, int K, int N, bf16_t* WT, LAS float* scr, int item, int lane) {
    const int nblk = N / 64, kb = item / nblk, nb = item % nblk, k0 = 64 * kb, n0 = 64 * nb;
    const int kq = lane >> 4, col = 4 * (lane & 15);
    const float* src = W + (size_t)(k0 + kq) * N + n0 + col;
    f32x4 v[16];
#pragma unroll
    for (int i = 0; i < 16; ++i) v[i] = *(const f32x4*)(src + (size_t)(4 * i) * N);
    if (gain) {
#pragma unroll
        for (int i = 0; i < 16; ++i) v[i] = v[i] * gain[k0 + 4 * i + kq];
    }
#pragma unroll
    for (int i = 0; i < 16; ++i) { LAS float* d = scr + (4 * i + kq) * 65 + col; d[0] = v[i][0]; d[1] = v[i][1]; d[2] = v[i][2]; d[3] = v[i][3]; }
    asm volatile("s_waitcnt lgkmcnt(0)" ::: "memory");
    const int c = lane & 7;
#pragma unroll
    for (int j = 0; j < 8; ++j) { const int n = (lane >> 3) + 8 * j; const LAS float* s = scr + (8 * c) * 65 + n;
        u32x4 o; o.x = cvt_pk_bf16(s[0 * 65], s[1 * 65]); o.y = cvt_pk_bf16(s[2 * 65], s[3 * 65]); o.z = cvt_pk_bf16(s[4 * 65], s[5 * 65]); o.w = cvt_pk_bf16(s[6 * 65], s[7 * 65]);
        const int na = n0 + n; *(u32x4*)(WT + ((size_t)((na >> 8) * (K >> 6) + kb) * 256 + (na & 255)) * 64 + 8 * c) = o; }
    asm volatile("s_waitcnt lgkmcnt(0)" ::: "memory");
}

typedef float f32x16 __attribute__((ext_vector_type(16)));
__device__ __forceinline__ float sigm(float x) { return __builtin_amdgcn_rcpf(1.0f + __expf(-x)); }

typedef float f32x2 __attribute__((ext_vector_type(2)));
__device__ __forceinline__ void conv_unit(LAS unsigned char* lds, int unit, const bf16_t* PROJ, bf16_t* MIX, const float* cw, const float* cb, const float* lng, const float* lnb, int tid_in) {
    int tid = tid_in; asm volatile("" : "+v"(tid));
    const int lane = tid & 63, wave = tid >> 6;
    const int tb = unit * 64, s0 = tb & (SEQ - 1), blk = wave >> 2, c0 = 128 * (wave & 3) + 2 * lane;
    LAS float* cv = (LAS float*)lds;
    __syncthreads();
    {
        f32x2 w[31];
#pragma unroll
        for (int j = 0; j < 31; ++j) w[j] = *(const f32x2*)(cw + j * 512 + c0);
        const f32x2 bias = *(const f32x2*)(cb + c0);
        f32x2 acc[32];
#pragma unroll
        for (int o = 0; o < 32; ++o) acc[o] = bias;
        const int p0 = s0 + blk * 32 - 30;
        int rr = tb + blk * 32 - 30;
#define CONV_LD2(da, dg, row) do { const bf16_t* p_ = PROJ + proj_off((row), C_CA + c0); da = *(const unsigned*)p_; dg = *(const unsigned*)(p_ + ((C_CG - C_CA) / 64) * 256 * 64); } while (0)
        unsigned ra[2][16], rg[2][16];
#pragma unroll
        for (int k = 0; k < 16; ++k) CONV_LD2(ra[0][k], rg[0][k], rr + k);
#pragma unroll
        for (int gi = 0; gi < 4; ++gi) {
            rr += 16; asm volatile("" : "+v"(rr));
            if (gi < 3) {
#pragma unroll
                for (int k = 0; k < 16; ++k) if (gi * 16 + 16 + k < 62) CONV_LD2(ra[(gi + 1) & 1][k], rg[(gi + 1) & 1][k], rr + k);
            }
#pragma unroll
            for (int k = 0; k < 16; ++k) { const int ii = gi * 16 + k; if (ii < 62) {
                const unsigned a = ra[gi & 1][k], gt = rg[gi & 1][k];
                f32x2 hv; hv.x = __uint_as_float(a << 16) * sigm(__uint_as_float(gt << 16)); hv.y = __uint_as_float(a & 0xffff0000u) * sigm(__uint_as_float(gt & 0xffff0000u));
                if ((p0 + ii) < 0) hv = (f32x2){0.f, 0.f};
#pragma unroll
                for (int o = 0; o < 32; ++o) { const int j = ii - o; if (j >= 0 && j <= 30) acc[o] += w[j] * hv; } } }
        }
#undef CONV_LD2
        LAS float* cvb = cv + blk * 32 * 512 + c0; asm volatile("" : "+v"(cvb));
#pragma unroll
        for (int o = 0; o < 32; ++o) *(LAS f32x2*)(cvb + o * 512) = acc[o];
    }
    __syncthreads();
    {
        const f32x4 g0 = *(const f32x4*)(lng + 4 * lane), g1 = *(const f32x4*)(lng + 256 + 4 * lane), b0 = *(const f32x4*)(lnb + 4 * lane), b1 = *(const f32x4*)(lnb + 256 + 4 * lane);
        f32x4 v0[8], v1[8]; float red[8];
        const LAS float* cvr = cv + wave * 8 * 512 + 4 * lane;
#pragma unroll
        for (int r = 0; r < 8; ++r) { v0[r] = *(const LAS f32x4*)(cvr + r * 512); v1[r] = *(const LAS f32x4*)(cvr + r * 512 + 256);
            red[r] = ((v0[r][0] + v0[r][1]) + (v0[r][2] + v0[r][3])) + ((v1[r][0] + v1[r][1]) + (v1[r][2] + v1[r][3])); }
#pragma unroll
        for (int o = 1; o < 64; o <<= 1)
#pragma unroll
            for (int r = 0; r < 8; ++r) red[r] += shx(red[r], o, lane);
#pragma unroll
        for (int r = 0; r < 8; ++r) { const float mean = red[r] * (1.0f / 512.0f); v0[r] = v0[r] - mean; v1[r] = v1[r] - mean;
            red[r] = ((v0[r][0] * v0[r][0] + v0[r][1] * v0[r][1]) + (v0[r][2] * v0[r][2] + v0[r][3] * v0[r][3])) + ((v1[r][0] * v1[r][0] + v1[r][1] * v1[r][1]) + (v1[r][2] * v1[r][2] + v1[r][3] * v1[r][3])); }
#pragma unroll
        for (int o = 1; o < 64; o <<= 1)
#pragma unroll
            for (int r = 0; r < 8; ++r) red[r] += shx(red[r], o, lane);
#pragma unroll
        for (int r = 0; r < 8; ++r) { const float rstd = rsqrtf(red[r] * (1.0f / 512.0f) + EPS); v0[r] = v0[r] * rstd * g0 + b0; v1[r] = v1[r] * rstd * g1 + b1; float q2 = 0.f;
#pragma unroll
            for (int e = 0; e < 4; ++e) { v0[r][e] = v0[r][e] * sigm(v0[r][e]); v1[r][e] = v1[r][e] * sigm(v1[r][e]); q2 += v0[r][e] * v0[r][e] + v1[r][e] * v1[r][e]; }
            red[r] = q2; }
#pragma unroll
        for (int o = 1; o < 64; o <<= 1)
#pragma unroll
            for (int r = 0; r < 8; ++r) red[r] += shx(red[r], o, lane);
        bf16_t* orow = MIX + blk_off(tb + wave * 8, X_CONV + 4 * lane);
#pragma unroll
        for (int r = 0; r < 8; ++r) { const float r2 = rsqrtf(red[r] * (1.0f / 512.0f) + EPS); const f32x4 a = v0[r] * r2, c = v1[r] * r2;
            u32x2 o0, o1; o0.x = cvt_pk_bf16(a[0], a[1]); o0.y = cvt_pk_bf16(a[2], a[3]); o1.x = cvt_pk_bf16(c[0], c[1]); o1.y = cvt_pk_bf16(c[2], c[3]);
            *(u32x2*)(orow + r * 64) = o0; *(u32x2*)(orow + r * 64 + 4 * 256 * 64) = o1; }
    }
}

constexpr int SG_P = 136;
__device__ __forceinline__ void sgu_unit(LAS unsigned char* lds, int unit, const bf16_t* PROJ, bf16_t* MIX, const bf16_t* SW, const float* lng, const float* lnb, const float* sb, int tid_in) {
    int tid = tid_in; asm volatile("" : "+v"(tid));
    const int lane = tid & 63, wave = __builtin_amdgcn_readfirstlane(tid >> 6);
    const int tc = unit * 128;
    LAS bf16_t* Vt = (LAS bf16_t*)lds;
    LAS float* st = (LAS float*)(lds + 512 * SG_P * 2);
    __syncthreads();
    u32x4 raws[16];
#pragma unroll
    for (int rr = 0; rr < 16; ++rr) raws[rr] = *(const u32x4*)(PROJ + proj_off(tc + wave * 16 + rr, C_SV + 8 * lane));
#pragma unroll
    for (int rr = 0; rr < 16; ++rr) {
        const int j = wave * 16 + rr;
        const u32x4 raw = raws[rr];
        float v[8];
#pragma unroll
        for (int e = 0; e < 4; ++e) { v[2 * e] = __uint_as_float(raw[e] << 16); v[2 * e + 1] = __uint_as_float(raw[e] & 0xffff0000u); }
        float sm = 0.f;
#pragma unroll
        for (int e = 0; e < 8; ++e) sm += v[e];
        const float mean = wave_sum(sm, lane) * (1.0f / 512.0f); float q = 0.f;
#pragma unroll
        for (int e = 0; e < 8; ++e) { const float d = v[e] - mean; q += d * d; }
        const float rstd = rsqrtf(wave_sum(q, lane) * (1.0f / 512.0f) + EPS);
        if (lane == 0) { st[2 * j] = mean; st[2 * j + 1] = rstd; }
    }
    __syncthreads();
    {
        const int c = tid; const float g = lng[c], b = lnb[c];
        const bf16_t* src = PROJ + proj_off(tc, C_SV + c);
#pragma unroll 1
        for (int jb = 0; jb < 4; ++jb) {
            bf16_t rv[32];
#pragma unroll
            for (int e = 0; e < 32; ++e) rv[e] = src[(32 * jb + e) * 64];
#pragma unroll
            for (int jg = 0; jg < 4; ++jg) {
                float vn[8];
#pragma unroll
                for (int e = 0; e < 8; ++e) { const int j = 32 * jb + 8 * jg + e; vn[e] = (bf2f(rv[8 * jg + e]) - st[2 * j]) * st[2 * j + 1] * g + b; }
                u32x4 o; o.x = cvt_pk_bf16(vn[0], vn[1]); o.y = cvt_pk_bf16(vn[2], vn[3]); o.z = cvt_pk_bf16(vn[4], vn[5]); o.w = cvt_pk_bf16(vn[6], vn[7]);
                *(LAS u32x4*)(Vt + c * SG_P + 32 * jb + 8 * jg) = o;
            }
        }
    }
    __syncthreads();
    const int fr = lane & 15, fq = lane >> 4, irow = 16 * wave + fr, nks = (wave >> 1) + 1;
    f32x4 outv[8][4]; float ssq = 0.f;
    bf16x8 wa[2][4]; u32x2 ub[2][4]; float bs[2];
#define SGU_LOAD(buf, hh_) do { int hr = (hh_); asm volatile("" : "+s"(hr)); const bf16_t* swh = SW + ((size_t)(hr * 128 + irow) * 128 + 8 * fq); \
        _Pragma("unroll") for (int ks = 0; ks < 4; ++ks) wa[buf][ks] = *(const bf16x8*)(swh + 32 * ks); \
        const bf16_t* up = PROJ + proj_off(tc + irow, C_SU + hr * 64 + 4 * fq); \
        _Pragma("unroll") for (int nt = 0; nt < 4; ++nt) ub[buf][nt] = *(const u32x2*)(up + 16 * nt); \
        bs[buf] = sb[hr * 128 + irow]; } while (0)
    SGU_LOAD(0, 0);
#pragma unroll
    for (int h = 0; h < 8; ++h) {
        if (h < 7) SGU_LOAD((h + 1) & 1, h + 1);
        int hr = h; asm volatile("" : "+s"(hr));
        f32x4 acc[4];
#pragma unroll
        for (int nt = 0; nt < 4; ++nt) acc[nt] = (f32x4){0.f, 0.f, 0.f, 0.f};
        const LAS bf16_t* vth = Vt + (hr * 64 + fr) * SG_P + 8 * fq;
#pragma unroll
        for (int ks = 0; ks < 4; ++ks) if (ks < nks) {
#pragma unroll
            for (int nt = 0; nt < 4; ++nt) { const bf16x8 bf = *(const LAS bf16x8*)(vth + 16 * nt * SG_P + 32 * ks);
                acc[nt] = __builtin_amdgcn_mfma_f32_16x16x32_bf16(bf, wa[h & 1][ks], acc[nt], 0, 0, 0); }
        }
        const float bias = bs[h & 1];
#pragma unroll
        for (int nt = 0; nt < 4; ++nt) {
            const u32x2 ur = ub[h & 1][nt];
            f32x4 u; u[0] = __uint_as_float(ur.x << 16); u[1] = __uint_as_float(ur.x & 0xffff0000u); u[2] = __uint_as_float(ur.y << 16); u[3] = __uint_as_float(ur.y & 0xffff0000u);
            const f32x4 o = u * (acc[nt] + bias); outv[h][nt] = o; ssq += (o[0] * o[0] + o[1] * o[1]) + (o[2] * o[2] + o[3] * o[3]);
        }
    }
#undef SGU_LOAD
    ssq += shx(ssq, 16, lane); ssq += shx(ssq, 32, lane);
    const float r2 = rsqrtf(ssq * (1.0f / 512.0f) + EPS);
    int orow_r = tc + irow; asm volatile("" : "+v"(orow_r));
    bf16_t* orow = MIX + blk_off(orow_r, X_SGU + 4 * fq);
#pragma unroll
    for (int h = 0; h < 8; ++h)
#pragma unroll
        for (int nt = 0; nt < 4; ++nt) { const f32x4 o = outv[h][nt] * r2; u32x2 w; w.x = cvt_pk_bf16(o[0], o[1]); w.y = cvt_pk_bf16(o[2], o[3]); *(u32x2*)(orow + h * (256 * 64) + 16 * nt) = w; }
}

constexpr int AT_KP = 144, AT_VP = 520;
constexpr float LOG2E = 1.4426950408889634f;
__device__ __forceinline__ void attn_unit(LAS unsigned char* lds, int unit, const bf16_t* PROJ, bf16_t* MIX, float* AST, const float* gq, const float* gk, const float* sinks, int tid_in) {
    int tid = tid_in; asm volatile("" : "+v"(tid));
    const int lane = tid & 63, wave = __builtin_amdgcn_readfirstlane(tid >> 6);
    const int kvh = unit & 3, blk = (unit >> 2) & 15, b = unit >> 6;
    const int tb = b * SEQ + blk * 128, kb = tb - 128, jmin = blk == 0 ? 128 : 0;
    LAS unsigned char* Ks = lds; LAS unsigned char* Vt = lds + 256 * AT_KP; LAS float* ssx = (LAS float*)(lds + 256 * AT_KP + 64 * AT_VP);
    __syncthreads();
#pragma unroll
    for (int it = 0; it < 4; ++it) {
        const int idx = tid + 512 * it, kr = idx >> 3, c8 = idx & 7; const bool valid = kr >= jmin; const int row = valid ? kb + kr : tb;
        const u32x4 raw = *(const u32x4*)(PROJ + proj_off(row, C_K + kvh * 64 + c8 * 8));
        float v[8];
#pragma unroll
        for (int e = 0; e < 4; ++e) { v[2 * e] = __uint_as_float(raw[e] << 16); v[2 * e + 1] = __uint_as_float(raw[e] & 0xffff0000u); }
        float ss = 0.f;
#pragma unroll
        for (int e = 0; e < 8; ++e) ss += v[e] * v[e];
        ss += shx(ss, 1, lane); ss += shx(ss, 2, lane); ss += shx(ss, 4, lane);
        const float rk = valid ? rsqrtf(ss * (1.0f / 64.0f) + EPS) : 0.f;
        const f32x4 ga = *(const f32x4*)(gk + c8 * 8), gb = *(const f32x4*)(gk + c8 * 8 + 4);
        u32x4 o; o.x = cvt_pk_bf16(v[0] * rk * ga[0], v[1] * rk * ga[1]); o.y = cvt_pk_bf16(v[2] * rk * ga[2], v[3] * rk * ga[3]);
        o.z = cvt_pk_bf16(v[4] * rk * gb[0], v[5] * rk * gb[1]); o.w = cvt_pk_bf16(v[6] * rk * gb[2], v[7] * rk * gb[3]);
        *(LAS u32x4*)(Ks + kr * AT_KP + c8 * 16) = o;
    }
#pragma unroll
    for (int it = 0; it < 8; ++it) {
        const int idx = tid + 512 * it, d = idx & 63, kg = idx >> 6;
        unsigned short x[4];
#pragma unroll
        for (int e = 0; e < 4; ++e) { const int key = 4 * kg + e; const bool valid = key >= jmin; const int row = valid ? kb + key : tb;
            const bf16_t r = PROJ[proj_off(row, C_V + kvh * 64 + d)]; x[e] = valid ? r : (bf16_t)0; }
        u32x2 o; o.x = (unsigned)x[0] | ((unsigned)x[1] << 16); o.y = (unsigned)x[2] | ((unsigned)x[3] << 16);
        *(LAS u32x2*)(Vt + d * AT_VP + kg * 8) = o;
    }
    __syncthreads();
    const int g = wave >> 1, half = wave & 1, h = kvh * 4 + g, q = lane & 31, hh = lane >> 5;
    const float sink2 = sinks[h] * LOG2E;
    u32x4 qraw[2][4];
#pragma unroll
    for (int qt = 0; qt < 2; ++qt) { const bf16_t* qp = PROJ + proj_off(tb + half * 64 + qt * 32 + q, C_Q + h * 64 + 8 * hh);
#pragma unroll
        for (int ks = 0; ks < 4; ++ks) qraw[qt][ks] = *(const u32x4*)(qp + 16 * ks); }
#pragma unroll
    for (int qt = 0; qt < 2; ++qt) {
        const int i0 = half * 64 + qt * 32, i = i0 + q, kt0 = i0 >> 5;
        bf16x8 qf[4];
        {
            float ss = 0.f;
#pragma unroll
            for (int ks = 0; ks < 4; ++ks) {
#pragma unroll
                for (int e = 0; e < 4; ++e) { const float a = __uint_as_float(qraw[qt][ks][e] << 16), c = __uint_as_float(qraw[qt][ks][e] & 0xffff0000u); ss += a * a + c * c; } }
            ss += shx(ss, 32, lane);
            const float rq = rsqrtf(ss * (1.0f / 64.0f) + EPS) * (0.125f * LOG2E);
#pragma unroll
            for (int ks = 0; ks < 4; ++ks) { const f32x4 ga = *(const f32x4*)(gq + 16 * ks + 8 * hh), gb = *(const f32x4*)(gq + 16 * ks + 8 * hh + 4);
                u32x4 o;
#pragma unroll
                for (int e = 0; e < 4; ++e) { const float a = __uint_as_float(qraw[qt][ks][e] << 16), c = __uint_as_float(qraw[qt][ks][e] & 0xffff0000u);
                    const float g0 = e < 2 ? ga[2 * e] : gb[2 * e - 4], g1 = e < 2 ? ga[2 * e + 1] : gb[2 * e - 3]; o[e] = cvt_pk_bf16(a * rq * g0, c * rq * g1); }
                qf[ks] = __builtin_bit_cast(bf16x8, o); }
        }
        f32x16 S[5];
        const LAS unsigned char* kp = Ks + (32 * kt0 + q) * AT_KP + 16 * hh;
#pragma unroll
        for (int kt = 0; kt < 5; ++kt) {
#pragma unroll
            for (int r = 0; r < 16; ++r) S[kt][r] = 0.f;
#pragma unroll
            for (int ks = 0; ks < 4; ++ks) { const bf16x8 kf = *(const LAS bf16x8*)(kp + kt * 32 * AT_KP + ks * 32);
                S[kt] = __builtin_amdgcn_mfma_f32_32x32x16_bf16(kf, qf[ks], S[kt], 0, 0, 0); }
        }
        float mx = -1e30f; const int qa = q - 4 * hh;
#pragma unroll
        for (int kt = 0; kt < 5; ++kt) { const bool tv = 32 * (kt0 + kt) >= jmin;
#pragma unroll
            for (int r = 0; r < 16; ++r) { const int kl = (r & 3) + 8 * (r >> 2);
                bool ok = tv; if (kt == 0) ok = ok && (kl > qa); if (kt == 4) ok = ok && (kl <= qa);
                const float sv = ok ? S[kt][r] : -1e30f; S[kt][r] = sv; mx = fmaxf(mx, sv); } }
        mx = fmaxf(mx, shx(mx, 32, lane)); mx = fmaxf(mx, sink2);
        float sum = 0.f;
#pragma unroll
        for (int kt = 0; kt < 5; ++kt)
#pragma unroll
            for (int r = 0; r < 16; ++r) { const float p = __builtin_amdgcn_exp2f(S[kt][r] - mx); S[kt][r] = p; sum += p; }
        sum += shx(sum, 32, lane);
        const float inv = __builtin_amdgcn_rcpf(sum + __builtin_amdgcn_exp2f(sink2 - mx));
        f32x16 O[2];
#pragma unroll
        for (int r = 0; r < 16; ++r) { O[0][r] = 0.f; O[1][r] = 0.f; }
        const LAS unsigned char* vp = Vt + q * AT_VP + (32 * kt0 + 4 * hh) * 2;
#pragma unroll
        for (int kt = 0; kt < 5; ++kt)
#pragma unroll
            for (int s2 = 0; s2 < 2; ++s2) {
                u32x4 pw; pw.x = cvt_pk_bf16(S[kt][8 * s2 + 0], S[kt][8 * s2 + 1]); pw.y = cvt_pk_bf16(S[kt][8 * s2 + 2], S[kt][8 * s2 + 3]);
                pw.z = cvt_pk_bf16(S[kt][8 * s2 + 4], S[kt][8 * s2 + 5]); pw.w = cvt_pk_bf16(S[kt][8 * s2 + 6], S[kt][8 * s2 + 7]);
                const bf16x8 pf = __builtin_bit_cast(bf16x8, pw);
#pragma unroll
                for (int dt = 0; dt < 2; ++dt) {
                    const u32x2 lo = *(const LAS u32x2*)(vp + dt * 32 * AT_VP + (32 * kt + 16 * s2) * 2), hi2 = *(const LAS u32x2*)(vp + dt * 32 * AT_VP + (32 * kt + 16 * s2 + 8) * 2);
                    u32x4 vw; vw.x = lo.x; vw.y = lo.y; vw.z = hi2.x; vw.w = hi2.y;
                    O[dt] = __builtin_amdgcn_mfma_f32_32x32x16_bf16(__builtin_bit_cast(bf16x8, vw), pf, O[dt], 0, 0, 0);
                }
            }
        float ssq = 0.f;
        bf16_t* op = MIX + blk_off(tb + i, X_ATT + h * 64 + 4 * hh);
#pragma unroll
        for (int dt = 0; dt < 2; ++dt)
#pragma unroll
            for (int g4 = 0; g4 < 4; ++g4) { float o0 = O[dt][4 * g4] * inv, o1 = O[dt][4 * g4 + 1] * inv, o2 = O[dt][4 * g4 + 2] * inv, o3 = O[dt][4 * g4 + 3] * inv;
                ssq += (o0 * o0 + o1 * o1) + (o2 * o2 + o3 * o3); u32x2 w; w.x = cvt_pk_bf16(o0, o1); w.y = cvt_pk_bf16(o2, o3); *(u32x2*)(op + 32 * dt + 8 * g4) = w; }
        ssq += shx(ssq, 32, lane);
        if (hh == 0) ssx[g * 128 + i] = ssq;
    }
    __syncthreads();
    if (tid < 128) AST[(size_t)(tb + tid) * 4 + kvh] = (ssx[tid] + ssx[128 + tid]) + (ssx[256 + tid] + ssx[384 + tid]);
}

constexpr int I_IN = (DM / 64) * (DIN / 64), I_OUT = (DM / 64) * (DM / 64), I_UP = (DM / 64) * (DFF / 64), I_DN = (DFF / 64) * (DM / 64), I_L = I_IN + I_OUT + I_UP + I_DN;
__device__ __forceinline__ void convert_range(const Args& args, unsigned char* ws, int l, int lo_item, int hi_item, int gwi, int ngw, LAS float* scr, int lane) {
    for (int it = lo_item + gwi; it < hi_item; it += ngw) {
        int r = it;
        if (r < I_IN) { p0_transpose_item(args.in[2] + (size_t)l * DM * DIN, args.in[1] + l * DM, DM, DIN, (bf16_t*)(ws + WS_WIN + l * SZ_WIN), scr, r, lane); continue; } r -= I_IN;
        if (r < I_OUT) { p0_transpose_item(args.in[15] + (size_t)l * DM * DM, args.in[14] + l * DM, DM, DM, (bf16_t*)(ws + WS_WOUT + l * SZ_WOUT), scr, r, lane); continue; } r -= I_OUT;
        if (r < I_UP) { p0_transpose_item(args.in[17] + (size_t)l * DM * DFF, args.in[16] + l * DM, DM, DFF, (bf16_t*)(ws + WS_WUP + l * SZ_WUP), scr, r, lane); continue; } r -= I_UP;
        p0_transpose_item(args.in[18] + (size_t)l * DFF * DM, nullptr, DFF, DM, (bf16_t*)(ws + WS_WDN + l * SZ_WDN), scr, r, lane);
    }
}

#define XB_TMO      128
#define XB_XCNT(j)  (256  + 64 * (j))
#define XB_XSUB(j)  (1280 + 64 * (j))
#define XB_XGEN(j)  (2304 + 64 * (j))
#define XB_TOP      3328
#define XB_TOPGEN   3392
#define XCD_BAR_WORDS 3456
#define XB_SPIN_CAP (1u << 18)
__device__ __forceinline__ unsigned xb_ld(unsigned* p)              { return __hip_atomic_load(p, __ATOMIC_RELAXED, __HIP_MEMORY_SCOPE_AGENT); }
__device__ __forceinline__ unsigned xb_add(unsigned* p, unsigned v) { return __hip_atomic_fetch_add(p, v, __ATOMIC_RELAXED, __HIP_MEMORY_SCOPE_AGENT); }
__device__ __forceinline__ unsigned xb_xcc_id() { return (unsigned)__builtin_amdgcn_s_getreg((3 << 11) | 20) & 0xFu; }
#define XB_SPIN(cond, bar) do { unsigned _sp = 0; while (cond) { __builtin_amdgcn_s_sleep(1); \
    if ((++_sp & 255u) == 0u) { if (xb_ld(&(bar)[XB_TMO])) break; if (_sp > XB_SPIN_CAP) { atomicAdd(&(bar)[XB_TMO], 1u); break; } } } } while (0)
struct XcdBarrier { unsigned* bar; unsigned x; volatile LAS unsigned* st; };
__device__ __forceinline__ XcdBarrier xcd_barrier_post(unsigned* bar, volatile LAS unsigned* st) {
    XcdBarrier b; b.bar = bar; b.x = xb_xcc_id(); b.st = st;
    if (threadIdx.x == 0) (void)xb_add(&bar[XB_XCNT(b.x)], 1u);
    return b;
}
__device__ __forceinline__ void xcd_barrier_complete(unsigned* bar, unsigned x, unsigned& nloc, unsigned& nx) {
    const unsigned G = gridDim.x * gridDim.y * gridDim.z;
    unsigned sum, cnt, mine, sp = 0u;
    for (;;) {
        sum = 0u; cnt = 0u; mine = 0u;
#pragma unroll
        for (unsigned j = 0; j < 16; ++j) { const unsigned c = xb_ld(&bar[XB_XCNT(j)]); sum += c; cnt += (c > 0u) ? 1u : 0u; mine = (j == x) ? c : mine; }
        if (sum == G) break;
        __builtin_amdgcn_s_sleep(1);
        if ((++sp & 255u) == 0u) { if (xb_ld(&bar[XB_TMO])) break; if (sp > XB_SPIN_CAP) { atomicAdd(&bar[XB_TMO], 1u); break; } }
    }
    nloc = mine > 0u ? mine : 1u; nx = cnt > 0u ? cnt : 1u;
}
__device__ __forceinline__ void xcd_barrier(const XcdBarrier& b, int wave_s) {
    asm volatile("s_waitcnt vmcnt(0)" ::: "memory");
    __syncthreads();
    if (wave_s == 0 && lane_id() == 0) {
        unsigned* bar = b.bar;
        __builtin_amdgcn_s_waitcnt(0);
        unsigned nloc = b.st[0], nx = b.st[1];
        if (nloc == 0u) { xcd_barrier_complete(bar, b.x, nloc, nx); b.st[0] = nloc; b.st[1] = nx; }
        const unsigned old = xb_add(&bar[XB_XSUB(b.x)], 1u);
        const unsigned gen = old / nloc;
        if (old + 1u == (gen + 1u) * nloc) {
            __builtin_amdgcn_fence(__ATOMIC_RELEASE, "agent");
            asm volatile("s_waitcnt vmcnt(0)" ::: "memory");
            const unsigned og = xb_add(&bar[XB_TOP], 1u);
            const unsigned tg = og / nx;
            if (og + 1u == (tg + 1u) * nx) xb_add(&bar[XB_TOPGEN], 1u);
            else XB_SPIN(xb_ld(&bar[XB_TOPGEN]) == tg, bar);
            __builtin_amdgcn_fence(__ATOMIC_ACQUIRE, "agent");
            xb_add(&bar[XB_XGEN(b.x)], 1u);
            asm volatile("s_waitcnt vmcnt(0)" ::: "memory");
        } else {
            XB_SPIN(xb_ld(&bar[XB_XGEN(b.x)]) == gen, bar);
            __builtin_amdgcn_fence(__ATOMIC_ACQUIRE, "agent");
            asm volatile("s_waitcnt vmcnt(0)" ::: "memory");
        }
    }
    __syncthreads();
}

__global__ void __launch_bounds__(NTHREADS, 2) fwd(Args args) {
    extern __shared__ __attribute__((aligned(16))) unsigned char lds_raw[];
    LAS unsigned char* lds = (LAS unsigned char*)lds_raw;
    const int tid = threadIdx.x, lane = tid & 63, wave = __builtin_amdgcn_readfirstlane(tid >> 6);
    const int G = gridDim.x, bx = blockIdx.x;
    const int gw = bx * NWAVES + wave, NGW = G * NWAVES;
    unsigned char* ws = args.ws;
    bf16_t* XB = (bf16_t*)(ws + WS_XB); bf16_t* PROJ = (bf16_t*)(ws + WS_PROJ); bf16_t* MIX = (bf16_t*)(ws + WS_MIX); bf16_t* HB = (bf16_t*)(ws + WS_H);
    float* RSA = (float*)(ws + WS_RSA); float* RSB = (float*)(ws + WS_RSB); float* AST = (float*)(ws + WS_AST);
    const int lo = args.ph_lo, hi = args.ph_hi;
    const bool split = (G == 256) && (DEPTH == 2);
#if MK_ONE_LAUNCH
    cg::grid_group grid = cg::this_grid();
    volatile LAS unsigned* MISC = (volatile LAS unsigned*)(lds + LDS_BYTES - 64);
    if (tid < 16) MISC[tid] = 0u;
    __syncthreads();
    const XcdBarrier xbar = xcd_barrier_post((unsigned*)(ws + WS_BAR), MISC);
    if (hi > 1000) grid.sync();
#define SEAM(k) do { if ((k) + 1 < hi) xcd_barrier(xbar, wave); } while (0)
#else
#define SEAM(k) do { } while (0)
#endif
#define IN(k) (lo <= (k) && (k) < hi)

    if (IN(0)) {
        LAS float* scr = (LAS float*)(lds + wave * 16640);
        convert_range(args, ws, 0, 0, I_L, gw, NGW, scr, lane);
        if (!split) convert_range(args, ws, 1, 0, I_L, gw, NGW, scr, lane);
        for (int i = bx * NTHREADS + tid; i < DEPTH * 8 * 128 * 128; i += G * NTHREADS) {
            const int ii = (i >> 7) & 127, jj = i & 127; ((bf16_t*)(ws + WS_SGUW))[i] = jj <= ii ? f2bf(args.in[12][i]) : (bf16_t)0; }
        const float* x = args.in[0];
        for (int m = 2 * gw; m < M; m += 2 * NGW) {
            const f32x4* xr = (const f32x4*)(x + (size_t)m * DM) + lane; f32x4 v[16];
#pragma unroll
            for (int j = 0; j < 16; ++j) v[j] = xr[64 * j];
            float ss0 = 0.f, ss1 = 0.f;
#pragma unroll
            for (int j = 0; j < 16; ++j) { const float q = (v[j][0] * v[j][0] + v[j][1] * v[j][1]) + (v[j][2] * v[j][2] + v[j][3] * v[j][3]); if (j < 8) ss0 += q; else ss1 += q;
                u32x2 w; w.x = cvt_pk_bf16(v[j][0], v[j][1]); w.y = cvt_pk_bf16(v[j][2], v[j][3]); *(u32x2*)(XB + blk_off(m + (j >> 3), 4 * lane + 256 * (j & 7))) = w; }
            ss0 = wave_sum(ss0, lane); ss1 = wave_sum(ss1, lane); if (lane == 0) { RSA[m] = ss0; RSA[m + 1] = ss1; }
        }
        SEAM(0);
    }
    for (int l = 0; l < DEPTH; ++l) {
        const int pb = 1 + 5 * l;
        if (IN(pb)) {
            pg8::Gemm g{XB, (const bf16_t*)(ws + WS_WIN + l * SZ_WIN), M, DIN, DM}; pg8::StaticOrder S; S.init(M, DIN, G, bx);
            pg8::EpiScaleBf16<0, true> E{PROJ, DIN, RSA + (size_t)l * M, 1.0f / DM};
            pg8::gemm_phase<pg8::EpiScaleBf16<0, true>, true, true, true>(lds, g, S, E, wave);
            if (split && bx >= 128) {
                int t_ = wave * 64 + lane_id(); asm volatile("" : "+v"(t_));
                LAS float* scr = (LAS float*)(lds + wave * 16640);
                if (l == 0) convert_range(args, ws, 1, 0, I_IN + I_OUT + I_UP, (bx - 128) * NWAVES + wave, 128 * NWAVES, scr, t_ & 63);
                else convert_range(args, ws, 1, I_IN + I_OUT + I_UP, I_L, (bx - 128) * NWAVES + wave, 128 * NWAVES, scr, t_ & 63);
            }
            SEAM(pb);
        }
        if (IN(pb + 1)) {
            int t_ = wave * 64 + lane_id(); asm volatile("" : "+v"(t_));
            for (int u = bx; u < 512; u += G) attn_unit(lds, u, PROJ, MIX, AST, args.in[3] + l * 64, args.in[4] + l * 64, args.in[5] + l * 16, t_);
            for (int u = bx; u < 256; u += G) {
                if (u < 128) sgu_unit(lds, u, PROJ, MIX, (const bf16_t*)(ws + WS_SGUW + l * SZ_SGUW), args.in[10] + l * 512, args.in[11] + l * 512, args.in[13] + l * 8 * 128, t_);
                else { conv_unit(lds, 2 * (u - 128), PROJ, MIX, args.in[6] + l * 31 * 512, args.in[7] + l * 512, args.in[8] + l * 512, args.in[9] + l * 512, t_);
                       conv_unit(lds, 2 * (u - 128) + 1, PROJ, MIX, args.in[6] + l * 31 * 512, args.in[7] + l * 512, args.in[8] + l * 512, args.in[9] + l * 512, t_); }
            }
            SEAM(pb + 1);
        }
        if (IN(pb + 2)) {
            pg8::Gemm g{MIX, (const bf16_t*)(ws + WS_WOUT + l * SZ_WOUT), M, DM, DM}; pg8::StaticOrder S; S.init(M, DM, G, bx);
            pg8::EpiRes<16, false> E{XB, nullptr, RSB + (size_t)l * M, AST, DM};
            pg8::gemm_phase<pg8::EpiRes<16, false>, true, true, true>(lds, g, S, E, wave);
            SEAM(pb + 2);
        }
        if (IN(pb + 3)) {
            pg8::Gemm g{XB, (const bf16_t*)(ws + WS_WUP + l * SZ_WUP), M, DFF, DM}; pg8::StaticOrder S; S.init(M, DFF, G, bx, 2);
            pg8::EpiScaleBf16<1, true> E{HB, DFF, RSB + (size_t)l * M, 1.0f / DM};
            pg8::gemm_phase<pg8::EpiScaleBf16<1, true>, true, true, true>(lds, g, S, E, wave);
            SEAM(pb + 3);
        }
        if (IN(pb + 4)) {
            pg8::Gemm g{HB, (const bf16_t*)(ws + WS_WDN + l * SZ_WDN), M, DM, DFF}; pg8::StaticOrder S; S.init(M, DM, G, bx, 1);
            if (l == DEPTH - 1) { pg8::EpiRes<0, true> E{XB, args.out, nullptr, nullptr, DM}; pg8::gemm_phase<pg8::EpiRes<0, true>, true, true, true>(lds, g, S, E, wave); }
            else { pg8::EpiRes<0, false> E{XB, nullptr, RSA + (size_t)(l + 1) * M, nullptr, DM}; pg8::gemm_phase<pg8::EpiRes<0, false>, true, true, true>(lds, g, S, E, wave); }
            SEAM(pb + 4);
        }
    }
#undef IN
#undef SEAM
}

constexpr int NPHASES = 1 + 5 * DEPTH;

extern "C" void kernel_launch(void* const* d_in, const int* in_sizes, int n_in, void* d_out, int out_size, void* d_ws, size_t ws_size, hipStream_t stream) {
    static int grid = 0;
    if (grid == 0) {
        if (n_in != 19 || in_sizes[0] != M * DM || out_size != M * DM || ws_size < WS_END) {
            fprintf(stderr, "kernel_launch: unexpected shapes (n_in %d, in0 %d, out %d, ws %zu need %zu); nothing launched\n", n_in, n_in > 0 ? in_sizes[0] : -1, out_size, ws_size, (size_t)WS_END); grid = -1; return; }
        int dev = 0, cus = 0, per_cu = 0;
        (void)hipGetDevice(&dev); (void)hipDeviceGetAttribute(&cus, hipDeviceAttributeMultiprocessorCount, dev);
        if (hipFuncSetAttribute((const void*)fwd, hipFuncAttributeMaxDynamicSharedMemorySize, LDS_BYTES) != hipSuccess) { fprintf(stderr, "kernel_launch: hipFuncSetAttribute failed\n"); grid = -1; return; }
        (void)hipOccupancyMaxActiveBlocksPerMultiprocessor(&per_cu, (const void*)fwd, NTHREADS, LDS_BYTES);
        if (per_cu < 1) fprintf(stderr, "kernel_launch: occupancy query says %d blocks per CU\n", per_cu);
        (void)hipGetLastError();
        grid = cus > 0 ? cus : 256;
    }
    if (grid < 0) return;
    (void)hipMemsetAsync((unsigned char*)d_ws + WS_BAR, 0, 16384 + (size_t)(2 * DEPTH) * M * 4, stream);
    Args a{};
    for (int i = 0; i < 19; ++i) a.in[i] = (const float*)d_in[i];
    a.out = (float*)d_out; a.ws = (unsigned char*)d_ws;
#if MK_ONE_LAUNCH
    a.ph_lo = 0; a.ph_hi = NPHASES;
    void* kargs[] = {&a};
    hipError_t e = hipLaunchCooperativeKernel((const void*)fwd, dim3(grid), dim3(NTHREADS), kargs, LDS_BYTES, stream);
    if (e != hipSuccess) fprintf(stderr, "cooperative launch failed: %s (grid %d)\n", hipGetErrorString(e), grid);
#else
    for (int p = 0; p < NPHASES; ++p) {
        a.ph_lo = p; a.ph_hi = p + 1;
        hipLaunchKernelGGL(fwd, dim3(grid), dim3(NTHREADS), LDS_BYTES, stream, a);
    }
#endif
}
```

```cpp
#include <hip/hip_runtime.h>
#include <hip/hip_cooperative_groups.h>
#include <cstdio>
#include <cstdint>
namespace cg = cooperative_groups;

#ifndef MK_ONE_LAUNCH
#define MK_ONE_LAUNCH 1
#endif

constexpr int DM = 2048, SEQ = 2048, NB = 8, M = NB * SEQ, DIN = 3584, DFF = 8192, DEPTH = 2;
constexpr int C_Q = 0, C_K = 1024, C_V = 1280, C_CA = 1536, C_CG = 2048, C_SU = 2560, C_SV = 3072;
constexpr int X_ATT = 0, X_CONV = 1024, X_SGU = 1536;
constexpr float EPS = 1e-6f;

#define LAS __attribute__((address_space(3)))
typedef unsigned short bf16_t;
typedef short bf16x8 __attribute__((ext_vector_type(8)));
typedef float f32x4 __attribute__((ext_vector_type(4)));
typedef unsigned u32x4 __attribute__((ext_vector_type(4)));
typedef unsigned u32x2 __attribute__((ext_vector_type(2)));

__device__ __forceinline__ unsigned cvt_pk_bf16(float lo, float hi) { unsigned r; asm volatile("v_cvt_pk_bf16_f32 %0, %1, %2" : "=v"(r) : "v"(lo), "v"(hi)); return r; }
__device__ __forceinline__ float bf2f(bf16_t b) { return __uint_as_float(((unsigned)b) << 16); }
__device__ __forceinline__ bf16_t f2bf(float f) { return (bf16_t)(cvt_pk_bf16(f, 0.f) & 0xffffu); }
__device__ __forceinline__ int lane_id() { int x; asm volatile("v_mbcnt_lo_u32_b32 %0, -1, 0\n\tv_mbcnt_hi_u32_b32 %0, -1, %0" : "=v"(x)); return x; }
__device__ __forceinline__ float shx(float v, int o, int lane) { return __int_as_float(__builtin_amdgcn_ds_bpermute((lane ^ o) << 2, __float_as_int(v))); }
__device__ __forceinline__ float shl(float v, int src) { return __int_as_float(__builtin_amdgcn_ds_bpermute(src << 2, __float_as_int(v))); }
__device__ __forceinline__ float wave_sum(float v, int lane) {
#pragma unroll
    for (int o = 1; o < 64; o <<= 1) v += shx(v, o, lane);
    return v;
}
__device__ __forceinline__ float wave_max(float v, int lane) {
#pragma unroll
    for (int o = 1; o < 64; o <<= 1) v = fmaxf(v, shx(v, o, lane));
    return v;
}

__device__ __forceinline__ size_t blk_off(int row, int col) { return (((size_t)(row >> 8) * (DM / 64) + (col >> 6)) * 256 + (row & 255)) * 64 + (col & 63); }

__device__ __forceinline__ ptrdiff_t proj_off(int row, int col) { return (((ptrdiff_t)(row >> 8) * (DIN / 64) + (col >> 6)) * 256 + (row & 255)) * 64 + (col & 63); }

namespace pg8 {
constexpr int BM = 256, BK = 64, HALF = 128, HTB = HALF * BK * 2, STAGE_BYTES = 8 * HTB, NXCD = 8, WGM = 8;
__host__ __device__ __forceinline__ int lds_byte(int r, int c) { const int st = (r >> 4) * 2 + (c >> 5), rr = r & 15, cc = c & 31, ob = rr * 64 + cc * 2; return st * 1024 + (ob ^ (((ob >> 9) & 1) << 5)); }
__host__ __device__ __forceinline__ void stage_rc(int b, int& R, int& C) { const int st = b / 1024, sb = b % 1024, swz = sb ^ (((sb >> 9) & 1) << 5); R = (st >> 1) * 16 + swz / 64; C = (st & 1) * 32 + (swz % 64) / 2; }
__host__ __device__ __forceinline__ int perm32(int rho) { const int n = rho >> 4, i = rho & 15; return 8 * (i >> 2) + 4 * n + (i & 3); }

struct Unit { int pm, pn; };
struct Gemm { const bf16_t* A; const bf16_t* Bt; int M, N, K; };

struct StaticOrder {
    int nM, nN, nwg, G, c, pnfast;
    __host__ __device__ void init(int M_, int N_, int G_, int c_, int pnfast_ = 0) { nM = M_ / BM; nN = N_ / BM; nwg = nM * nN; G = G_; c = c_; pnfast = pnfast_; }
    __host__ __device__ bool next(int i, Unit& u) const {
        const long L = (long)i * G + c; if (L >= nwg) return false;
        int wgid = (int)L; { const int q = nwg / NXCD, r = nwg % NXCD, xcd = wgid % NXCD, off = wgid / NXCD; wgid = (xcd < r ? xcd * (q + 1) : r * (q + 1) + (xcd - r) * q) + off; }
        const int nig = WGM * nN, gid = wgid / nig, fm = gid * WGM, gsz = (nM - fm) < WGM ? (nM - fm) : WGM;
        if (pnfast == 3) { const int j = wgid % nig, rnd = j >> 5, k = j & 31; u.pn = 8 * (rnd & 3) + (k & 7); u.pm = fm + 4 * (rnd >> 2) + (k >> 3); }
        else if (pnfast == 2) { const int j = wgid % nig, rnd = j >> 5, k = j & 31; u.pn = 8 * (rnd >> 1) + (k & 7); u.pm = fm + 4 * (rnd & 1) + (k >> 3); }
        else if (pnfast) { u.pn = (wgid % nig) % nN; u.pm = fm + (wgid % nig) / nN; } else { u.pm = fm + ((wgid % nig) % gsz); u.pn = (wgid % nig) / gsz; }
        return true;
    }
};

template <int ACT, bool OBLK = false> struct EpiScaleBf16 {
    static constexpr bool PERM = true; static constexpr int MID_T = 0;
    bf16_t* O; int ldc; const float* rowss; float inv_n;
    __device__ __forceinline__ void mid(f32x4 (&)[2][2][4][2], const Unit&, int, int) const {}
    __device__ __forceinline__ void prefetch(float (&pre)[8], const Unit& u, int wr, int fr) const {
        const float* p = rowss + u.pm * BM + wr * 64 + fr;
#pragma unroll
        for (int ai = 0; ai < 2; ++ai)
#pragma unroll
            for (int m = 0; m < 4; ++m) pre[ai * 4 + m] = p[ai * HALF + m * 16];
    }
    __device__ __forceinline__ void operator()(const f32x4 (&acc)[2][2][4][2], const float (&pre)[8], const Unit& u, int wr, int wc, int fr, int fq) const {
        const int row0 = u.pm * BM + wr * 64 + fr; const int col0 = u.pn * BM + wc * 32 + 8 * fq;
#pragma unroll
        for (int ai = 0; ai < 2; ++ai)
#pragma unroll
            for (int m = 0; m < 4; ++m) { const int row = row0 + ai * HALF + m * 16; const float rs = rsqrtf(pre[ai * 4 + m] * inv_n + EPS);
                bf16_t* rowp = OBLK ? O + (((size_t)u.pm * (ldc >> 6) + (col0 >> 6)) * 256 + (row & 255)) * 64 + (col0 & 63) : O + (size_t)row * ldc + col0;
#pragma unroll
                for (int bj = 0; bj < 2; ++bj) { f32x4 v0 = acc[ai][bj][m][0] * rs, v1 = acc[ai][bj][m][1] * rs;
                    if (ACT == 1) {
#pragma unroll
                        for (int e = 0; e < 4; ++e) { float a = fmaxf(v0[e], 0.f), b = fmaxf(v1[e], 0.f); v0[e] = a * a; v1[e] = b * b; } }
                    u32x4 w; w.x = cvt_pk_bf16(v0[0], v0[1]); w.y = cvt_pk_bf16(v0[2], v0[3]); w.z = cvt_pk_bf16(v1[0], v1[1]); w.w = cvt_pk_bf16(v1[2], v1[3]);
                    *(u32x4*)(rowp + (OBLK ? bj * (HALF / 64) * 256 * 64 : bj * HALF)) = w; } }
    }
};
template <int MIDT, bool FINAL> struct EpiRes {
    static constexpr bool PERM = true; static constexpr int MID_T = MIDT;
    bf16_t* xb; float* outf; float* rowss_out; const float* astat; int ldc;
    __device__ __forceinline__ void mid(f32x4 (&acc)[2][2][4][2], const Unit& u, int wr, int fr) const {
        const int row0 = u.pm * BM + wr * 64 + fr;
#pragma unroll
        for (int ai = 0; ai < 2; ++ai)
#pragma unroll
            for (int m = 0; m < 4; ++m) { const int row = row0 + ai * HALF + m * 16; const f32x4 s = *(const f32x4*)(astat + (size_t)row * 4);
                const float r1 = rsqrtf(((s[0] + s[1]) + (s[2] + s[3])) * (1.0f / 1024.0f) + EPS);
#pragma unroll
                for (int bj = 0; bj < 2; ++bj)
#pragma unroll
                    for (int n = 0; n < 2; ++n) acc[ai][bj][m][n] = acc[ai][bj][m][n] * r1;
                asm volatile("" ::: "memory"); }
    }
    __device__ __forceinline__ void prefetch(float (&)[8], const Unit&, int, int) const {}
    __device__ __forceinline__ void operator()(const f32x4 (&acc)[2][2][4][2], const float (&)[8], const Unit& u, int wr, int wc, int fr, int fq) const {
        const int row0 = u.pm * BM + wr * 64 + fr; const int col0 = u.pn * BM + wc * 32 + 8 * fq, lane = fr + 16 * fq;
        u32x4 bv[2][4][2];
#pragma unroll
        for (int ai = 0; ai < 2; ++ai)
#pragma unroll
            for (int m = 0; m < 4; ++m) { const bf16_t* rp = xb + blk_off(row0 + ai * HALF + m * 16, col0);
#pragma unroll
                for (int bj = 0; bj < 2; ++bj) bv[ai][m][bj] = *(const u32x4*)(rp + bj * (2 * 256 * 64)); }
#pragma unroll
        for (int ai = 0; ai < 2; ++ai)
#pragma unroll
            for (int m = 0; m < 4; ++m) { const int row = row0 + ai * HALF + m * 16; const size_t off = (size_t)row * ldc + col0; float ss = 0.f;
#pragma unroll
                for (int bj = 0; bj < 2; ++bj) { const u32x4 b = bv[ai][m][bj]; f32x4 o0, o1;
                    o0[0] = __uint_as_float(b.x << 16); o0[1] = __uint_as_float(b.x & 0xffff0000u); o0[2] = __uint_as_float(b.y << 16); o0[3] = __uint_as_float(b.y & 0xffff0000u);
                    o1[0] = __uint_as_float(b.z << 16); o1[1] = __uint_as_float(b.z & 0xffff0000u); o1[2] = __uint_as_float(b.w << 16); o1[3] = __uint_as_float(b.w & 0xffff0000u);
                    o0 = o0 + acc[ai][bj][m][0]; o1 = o1 + acc[ai][bj][m][1];
                    if (FINAL) { *(f32x4*)(outf + off + bj * HALF) = o0; *(f32x4*)(outf + off + bj * HALF + 4) = o1; }
                    else { u32x4 w; w.x = cvt_pk_bf16(o0[0], o0[1]); w.y = cvt_pk_bf16(o0[2], o0[3]); w.z = cvt_pk_bf16(o1[0], o1[1]); w.w = cvt_pk_bf16(o1[2], o1[3]);
                        *(u32x4*)(xb + blk_off(row, col0) + bj * (2 * 256 * 64)) = w; }
                    ss += ((o0[0] * o0[0] + o0[1] * o0[1]) + (o0[2] * o0[2] + o0[3] * o0[3])) + ((o1[0] * o1[0] + o1[1] * o1[1]) + (o1[2] * o1[2] + o1[3] * o1[3])); }
                if (!FINAL) { if (rowss_out) { ss += shx(ss, 16, lane); ss += shx(ss, 32, lane); if (fq == 0) atomicAdd(rowss_out + row, ss); } } }
    }
};

template <class Epi, bool ALIGN_EPI, bool ABLK = false, bool BBLK = false>
__device__ __forceinline__ void gemm_phase(LAS unsigned char* lds, const Gemm g, const StaticOrder& S, const Epi& E, int wave_s) {
    int tid = wave_s * 64 + lane_id(); asm volatile("" : "+v"(tid));
    const int wid = __builtin_amdgcn_readfirstlane(tid >> 6), lane = tid & 63, wr = wid >> 2, wc = wid & 3, fr = lane & 15, fq = lane >> 4;
    const int K = g.K, nt = K / BK;
    unsigned voffA, voffB;
    const int pitchA = ABLK ? 64 : K, pitchB = BBLK ? 64 : K;
    { int R, C; stage_rc(tid * 16, R, C); const int Rb = Epi::PERM ? ((R & ~31) + perm32(R & 31)) : R; voffA = (unsigned)(R * pitchA + C) * 2u; voffB = (unsigned)(Rb * pitchB + C) * 2u; }
    const size_t r64A = (size_t)64 * pitchA * 2, r64B = (size_t)64 * pitchB * 2;
    const size_t kstepA = ABLK ? (size_t)(BM * BK * 2) : (size_t)(BK * 2), kstepB = BBLK ? (size_t)(BM * BK * 2) : (size_t)(BK * 2);
    const size_t hstepA = (size_t)HALF * pitchA * 2, hstepB = (size_t)HALF * pitchB * 2;
    const size_t tstep = (size_t)BM * K * 2;
    const unsigned ldsw = (unsigned)wid * 1024u;
    const int aoff = lds_byte(wr * 64 + fr, fq * 8), boff = lds_byte(wc * 32 + fr, fq * 8);
#define PG8_SA(b, h) (((b) * 2 + (h)) * HTB)
#define PG8_SB(b, h) ((4 + (b) * 2 + (h)) * HTB)
#define PG8_STAGE(bufoff, gbase, voff, r64) do { _Pragma("unroll") for (int _i = 0; _i < 2; ++_i) \
        __builtin_amdgcn_global_load_lds((const unsigned*)((const char*)(gbase) + _i * r64 + (voff)), (LAS unsigned*)(lds + (bufoff) + ldsw + _i * 8192), 16, 0, 0); } while (0)
#define PG8_LDA(dst, b, h) do { _Pragma("unroll") for (int m = 0; m < 4; ++m) _Pragma("unroll") for (int k = 0; k < 2; ++k) dst[m][k] = *(const LAS bf16x8*)(lds + PG8_SA(b, h) + aoff + m * 2048 + k * 1024); } while (0)
#define PG8_LDB(dst, b, h) do { _Pragma("unroll") for (int n = 0; n < 2; ++n) _Pragma("unroll") for (int k = 0; k < 2; ++k) dst[n][k] = *(const LAS bf16x8*)(lds + PG8_SB(b, h) + boff + n * 2048 + k * 1024); } while (0)
#define PG8_MMA(ai, bj, At, Bt) do { __builtin_amdgcn_s_setprio(1); _Pragma("unroll") for (int m = 0; m < 4; ++m) _Pragma("unroll") for (int n = 0; n < 2; ++n) _Pragma("unroll") for (int k = 0; k < 2; ++k) \
        acc[ai][bj][m][n] = __builtin_amdgcn_mfma_f32_16x16x32_bf16(Bt[n][k], At[m][k], acc[ai][bj][m][n], 0, 0, 0); __builtin_amdgcn_s_setprio(0); } while (0)
#define PG8_WAIT_V(n) asm volatile("s_waitcnt vmcnt(" #n ")" ::: "memory")
#define PG8_WAIT_L(n) asm volatile("s_waitcnt lgkmcnt(" #n ")" ::: "memory")
#define PG8_BAR __builtin_amdgcn_s_barrier()
#define PG8_SCHED __builtin_amdgcn_sched_barrier(0)
    Unit cur, nxt; int ui = 0;
    if (!S.next(0, cur)) return;
    f32x4 acc[2][2][4][2];
#pragma unroll
    for (int a = 0; a < 2; ++a)
#pragma unroll
        for (int b = 0; b < 2; ++b)
#pragma unroll
            for (int m = 0; m < 4; ++m)
#pragma unroll
                for (int n = 0; n < 2; ++n) acc[a][b][m][n] = (f32x4){0.f, 0.f, 0.f, 0.f};
    bf16x8 At[4][2], B0[2][2], B1[2][2];
    float pre[8];
#pragma unroll
    for (int k = 0; k < 8; ++k) pre[k] = 0.f;
    const char* cA = (const char*)g.A + (size_t)cur.pm * tstep; const char* cB = (const char*)g.Bt + (size_t)cur.pn * tstep;
    PG8_STAGE(PG8_SB(0, 0), cB, voffB, r64B); PG8_STAGE(PG8_SB(0, 1), cB + hstepB, voffB, r64B); PG8_STAGE(PG8_SA(0, 0), cA, voffA, r64A); PG8_STAGE(PG8_SA(0, 1), cA + hstepA, voffA, r64A);
    PG8_STAGE(PG8_SB(1, 0), cB + kstepB, voffB, r64B); PG8_STAGE(PG8_SA(1, 0), cA + kstepA, voffA, r64A); PG8_STAGE(PG8_SB(1, 1), cB + hstepB + kstepB, voffB, r64B);
    if (wr == 1) PG8_BAR;
    PG8_WAIT_V(8); PG8_BAR;
    PG8_WAIT_V(6); PG8_BAR;
    for (;;) {
        const bool has_next = S.next(ui + 1, nxt);
        const char* nA = has_next ? (const char*)g.A + (size_t)nxt.pm * tstep : cA; const char* nB = has_next ? (const char*)g.Bt + (size_t)nxt.pn * tstep : cB;
        for (int t = 0; t < nt; t += 2) {
            if constexpr (Epi::MID_T > 0) { if (t == Epi::MID_T) E.mid(acc, cur, wr, fr); }
            const bool last = (t == nt - 2);
            if (last) E.prefetch(pre, cur, wr, fr);
            const char* a1 = cA + (size_t)(t + 1) * kstepA;
            const char* a2 = last ? nA : cA + (size_t)(t + 2) * kstepA; const char* b2 = last ? nB : cB + (size_t)(t + 2) * kstepB;
            const char* a3 = a2 + kstepA; const char* b3 = b2 + kstepB;
            PG8_LDB(B0, 0, 0); PG8_LDB(B1, 0, 1); PG8_SCHED; PG8_LDA(At, 0, 0); PG8_STAGE(PG8_SA(1, 1), a1 + hstepA, voffA, r64A);
            PG8_WAIT_V(8); PG8_WAIT_L(0); PG8_BAR; PG8_MMA(0, 0, At, B0); PG8_MMA(0, 1, At, B1); PG8_BAR; PG8_SCHED;
            PG8_LDA(At, 0, 1); PG8_STAGE(PG8_SB(0, 0), b2, voffB, r64B); PG8_STAGE(PG8_SB(0, 1), b2 + hstepB, voffB, r64B); PG8_STAGE(PG8_SA(0, 0), a2, voffA, r64A);
            PG8_WAIT_V(8); PG8_WAIT_L(0); PG8_BAR; PG8_MMA(1, 0, At, B0); PG8_MMA(1, 1, At, B1); PG8_BAR; PG8_SCHED;
            PG8_LDB(B0, 1, 0); PG8_LDB(B1, 1, 1); PG8_SCHED; PG8_LDA(At, 1, 0); PG8_STAGE(PG8_SA(0, 1), a2 + hstepA, voffA, r64A);
            PG8_WAIT_V(8); PG8_WAIT_L(0); PG8_BAR; PG8_MMA(0, 0, At, B0); PG8_MMA(0, 1, At, B1); PG8_BAR; PG8_SCHED;
            PG8_LDA(At, 1, 1); PG8_STAGE(PG8_SB(1, 0), b3, voffB, r64B); PG8_STAGE(PG8_SB(1, 1), b3 + hstepB, voffB, r64B); PG8_STAGE(PG8_SA(1, 0), a3, voffA, r64A);
            PG8_WAIT_V(8); PG8_WAIT_L(0); PG8_BAR; PG8_MMA(1, 0, At, B0); PG8_MMA(1, 1, At, B1); PG8_BAR; PG8_SCHED;
        }
        if constexpr (ALIGN_EPI) { if (wr == 0) PG8_BAR; }
        E(acc, pre, cur, wr, wc, fr, fq);
        if (!has_next) break;
#pragma unroll
        for (int a = 0; a < 2; ++a)
#pragma unroll
            for (int b = 0; b < 2; ++b)
#pragma unroll
                for (int m = 0; m < 4; ++m)
#pragma unroll
                    for (int n = 0; n < 2; ++n) acc[a][b][m][n] = (f32x4){0.f, 0.f, 0.f, 0.f};
        cur = nxt; cA = nA; cB = nB; ++ui;
        if constexpr (ALIGN_EPI) { if (wr == 1) PG8_BAR; }
    }
    PG8_WAIT_V(0);
    if constexpr (!ALIGN_EPI) { if (wr == 0) PG8_BAR; }
    PG8_BAR;
#undef PG8_SA
#undef PG8_SB
#undef PG8_STAGE
#undef PG8_LDA
#undef PG8_LDB
#undef PG8_MMA
#undef PG8_WAIT_V
#undef PG8_WAIT_L
#undef PG8_BAR
#undef PG8_SCHED
}
}

constexpr int NWAVES = 8, NTHREADS = 512;
constexpr int RING_BYTES = 131072, LDS_BYTES = 147456;
constexpr size_t MiB = 1u << 20;
constexpr size_t SZ_WIN = (size_t)DIN * DM * 2, SZ_WOUT = (size_t)DM * DM * 2, SZ_WUP = (size_t)DFF * DM * 2, SZ_WDN = (size_t)DM * DFF * 2, SZ_SGUW = (size_t)8 * 128 * 128 * 2;
constexpr size_t WS_WIN = 0;
constexpr size_t WS_WOUT = WS_WIN + DEPTH * SZ_WIN;
constexpr size_t WS_WUP = WS_WOUT + DEPTH * SZ_WOUT;
constexpr size_t WS_WDN = WS_WUP + DEPTH * SZ_WUP;
constexpr size_t WS_SGUW = WS_WDN + DEPTH * SZ_WDN;
constexpr size_t WS_BAR = WS_SGUW + DEPTH * SZ_SGUW;
constexpr size_t WS_RSA = WS_BAR + 16384;
constexpr size_t WS_RSB = WS_RSA + (size_t)DEPTH * M * 4;
constexpr size_t WS_AST = WS_RSB + (size_t)DEPTH * M * 4;
constexpr size_t WS_XB = WS_AST + (size_t)M * 16;
constexpr size_t WS_R = WS_XB + (size_t)M * DM * 2;
constexpr size_t WS_PROJ = WS_R, WS_MIX = WS_R + (size_t)M * DIN * 2, WS_H = WS_R;
constexpr size_t WS_END = WS_R + (size_t)M * DFF * 2;
static_assert(WS_XB % 256 == 0 && WS_R % 256 == 0 && WS_MIX % 256 == 0, "alignment");

struct Args { const float* in[19]; float* out; unsigned char* ws; int ph_lo, ph_hi; };

__device__ __forceinline__ void p0_transpose_item(const float* W, const float* gain, int K, int N, bf16_t* WT, LAS float* scr, int item, int lane) {
    const int nblk = N / 64, kb = item / nblk, nb = item % nblk, k0 = 64 * kb, n0 = 64 * nb;
    const int kq = lane >> 4, col = 4 * (lane & 15);
    const float* src = W + (size_t)(k0 + kq) * N + n0 + col;
    f32x4 v[16];
#pragma unroll
    for (int i = 0; i < 16; ++i) v[i] = *(const f32x4*)(src + (size_t)(4 * i) * N);
    if (gain) {
#pragma unroll
        for (int i = 0; i < 16; ++i) v[i] = v[i] * gain[k0 + 4 * i + kq];
    }
#pragma unroll
    for (int i = 0; i < 16; ++i) { LAS float* d = scr + (4 * i + kq) * 65 + col; d[0] = v[i][0]; d[1] = v[i][1]; d[2] = v[i][2]; d[3] = v[i][3]; }
    asm volatile("s_waitcnt lgkmcnt(0)" ::: "memory");
    const int c = lane & 7;
#pragma unroll
    for (int j = 0; j < 8; ++j) { const int n = (lane >> 3) + 8 * j; const LAS float* s = scr + (8 * c) * 65 + n;
        u32x4 o; o.x = cvt_pk_bf16(s[0 * 65], s[1 * 65]); o.y = cvt_pk_bf16(s[2 * 65], s[3 * 65]); o.z = cvt_pk_bf16(s[4 * 65], s[5 * 65]); o.w = cvt_pk_bf16(s[6 * 65], s[7 * 65]);
        const int na = n0 + n; *(u32x4*)(WT + ((size_t)((na >> 8) * (K >> 6) + kb) * 256 + (na & 255)) * 64 + 8 * c) = o; }
    asm volatile("s_waitcnt lgkmcnt(0)" ::: "memory");
}

typedef float f32x16 __attribute__((ext_vector_type(16)));
__device__ __forceinline__ float sigm(float x) { return __builtin_amdgcn_rcpf(1.0f + __expf(-x)); }

typedef float f32x2 __attribute__((ext_vector_type(2)));
__device__ __forceinline__ void conv_unit(LAS unsigned char* lds, int unit, const bf16_t* PROJ, bf16_t* MIX, const float* cw, const float* cb, const float* lng, const float* lnb, int tid_in) {
    int tid = tid_in; asm volatile("" : "+v"(tid));
    const int lane = tid & 63, wave = tid >> 6;
    const int tb = unit * 64, s0 = tb & (SEQ - 1), blk = wave >> 2, c0 = 128 * (wave & 3) + 2 * lane;
    LAS float* cv = (LAS float*)lds;
    __syncthreads();
    {
        f32x2 w[31];
#pragma unroll
        for (int j = 0; j < 31; ++j) w[j] = *(const f32x2*)(cw + j * 512 + c0);
        const f32x2 bias = *(const f32x2*)(cb + c0);
        f32x2 acc[32];
#pragma unroll
        for (int o = 0; o < 32; ++o) acc[o] = bias;
        const int p0 = s0 + blk * 32 - 30;
        int rr = tb + blk * 32 - 30;
#define CONV_LD2(da, dg, row) do { const bf16_t* p_ = PROJ + proj_off((row), C_CA + c0); da = *(const unsigned*)p_; dg = *(const unsigned*)(p_ + ((C_CG - C_CA) / 64) * 256 * 64); } while (0)
        unsigned ra[2][16], rg[2][16];
#pragma unroll
        for (int k = 0; k < 16; ++k) CONV_LD2(ra[0][k], rg[0][k], rr + k);
#pragma unroll
        for (int gi = 0; gi < 4; ++gi) {
            rr += 16; asm volatile("" : "+v"(rr));
            if (gi < 3) {
#pragma unroll
                for (int k = 0; k < 16; ++k) if (gi * 16 + 16 + k < 62) CONV_LD2(ra[(gi + 1) & 1][k], rg[(gi + 1) & 1][k], rr + k);
            }
#pragma unroll
            for (int k = 0; k < 16; ++k) { const int ii = gi * 16 + k; if (ii < 62) {
                const unsigned a = ra[gi & 1][k], gt = rg[gi & 1][k];
                f32x2 hv; hv.x = __uint_as_float(a << 16) * sigm(__uint_as_float(gt << 16)); hv.y = __uint_as_float(a & 0xffff0000u) * sigm(__uint_as_float(gt & 0xffff0000u));
                if ((p0 + ii) < 0) hv = (f32x2){0.f, 0.f};
#pragma unroll
                for (int o = 0; o < 32; ++o) { const int j = ii - o; if (j >= 0 && j <= 30) acc[o] += w[j] * hv; } } }
        }
#undef CONV_LD2
        LAS float* cvb = cv + blk * 32 * 512 + c0; asm volatile("" : "+v"(cvb));
#pragma unroll
        for (int o = 0; o < 32; ++o) *(LAS f32x2*)(cvb + o * 512) = acc[o];
    }
    __syncthreads();
    {
        const f32x4 g0 = *(const f32x4*)(lng + 4 * lane), g1 = *(const f32x4*)(lng + 256 + 4 * lane), b0 = *(const f32x4*)(lnb + 4 * lane), b1 = *(const f32x4*)(lnb + 256 + 4 * lane);
        f32x4 v0[8], v1[8]; float red[8];
        const LAS float* cvr = cv + wave * 8 * 512 + 4 * lane;
#pragma unroll
        for (int r = 0; r < 8; ++r) { v0[r] = *(const LAS f32x4*)(cvr + r * 512); v1[r] = *(const LAS f32x4*)(cvr + r * 512 + 256);
            red[r] = ((v0[r][0] + v0[r][1]) + (v0[r][2] + v0[r][3])) + ((v1[r][0] + v1[r][1]) + (v1[r][2] + v1[r][3])); }
#pragma unroll
        for (int o = 1; o < 64; o <<= 1)
#pragma unroll
            for (int r = 0; r < 8; ++r) red[r] += shx(red[r], o, lane);
#pragma unroll
        for (int r = 0; r < 8; ++r) { const float mean = red[r] * (1.0f / 512.0f); v0[r] = v0[r] - mean; v1[r] = v1[r] - mean;
            red[r] = ((v0[r][0] * v0[r][0] + v0[r][1] * v0[r][1]) + (v0[r][2] * v0[r][2] + v0[r][3] * v0[r][3])) + ((v1[r][0] * v1[r][0] + v1[r][1] * v1[r][1]) + (v1[r][2] * v1[r][2] + v1[r][3] * v1[r][3])); }
#pragma unroll
        for (int o = 1; o < 64; o <<= 1)
#pragma unroll
            for (int r = 0; r < 8; ++r) red[r] += shx(red[r], o, lane);
#pragma unroll
        for (int r = 0; r < 8; ++r) { const float rstd = rsqrtf(red[r] * (1.0f / 512.0f) + EPS); v0[r] = v0[r] * rstd * g0 + b0; v1[r] = v1[r] * rstd * g1 + b1; float q2 = 0.f;
#pragma unroll
            for (int e = 0; e < 4; ++e) { v0[r][e] = v0[r][e] * sigm(v0[r][e]); v1[r][e] = v1[r][e] * sigm(v1[r][e]); q2 += v0[r][e] * v0[r][e] + v1[r][e] * v1[r][e]; }
            red[r] = q2; }
#pragma unroll
        for (int o = 1; o < 64; o <<= 1)
#pragma unroll
            for (int r = 0; r < 8; ++r) red[r] += shx(red[r], o, lane);
        bf16_t* orow = MIX + blk_off(tb + wave * 8, X_CONV + 4 * lane);
#pragma unroll
        for (int r = 0; r < 8; ++r) { const float r2 = rsqrtf(red[r] * (1.0f / 512.0f) + EPS); const f32x4 a = v0[r] * r2, c = v1[r] * r2;
            u32x2 o0, o1; o0.x = cvt_pk_bf16(a[0], a[1]); o0.y = cvt_pk_bf16(a[2], a[3]); o1.x = cvt_pk_bf16(c[0], c[1]); o1.y = cvt_pk_bf16(c[2], c[3]);
            *(u32x2*)(orow + r * 64) = o0; *(u32x2*)(orow + r * 64 + 4 * 256 * 64) = o1; }
    }
}

constexpr int SG_P = 136;
__device__ __forceinline__ void sgu_unit(LAS unsigned char* lds, int unit, const bf16_t* PROJ, bf16_t* MIX, const bf16_t* SW, const float* lng, const float* lnb, const float* sb, int tid_in) {
    int tid = tid_in; asm volatile("" : "+v"(tid));
    const int lane = tid & 63, wave = __builtin_amdgcn_readfirstlane(tid >> 6);
    const int tc = unit * 128;
    LAS bf16_t* Vt = (LAS bf16_t*)lds;
    LAS float* st = (LAS float*)(lds + 512 * SG_P * 2);
    __syncthreads();
    u32x4 raws[16];
#pragma unroll
    for (int rr = 0; rr < 16; ++rr) raws[rr] = *(const u32x4*)(PROJ + proj_off(tc + wave * 16 + rr, C_SV + 8 * lane));
#pragma unroll
    for (int rr = 0; rr < 16; ++rr) {
        const int j = wave * 16 + rr;
        const u32x4 raw = raws[rr];
        float v[8];
#pragma unroll
        for (int e = 0; e < 4; ++e) { v[2 * e] = __uint_as_float(raw[e] << 16); v[2 * e + 1] = __uint_as_float(raw[e] & 0xffff0000u); }
        float sm = 0.f;
#pragma unroll
        for (int e = 0; e < 8; ++e) sm += v[e];
        const float mean = wave_sum(sm, lane) * (1.0f / 512.0f); float q = 0.f;
#pragma unroll
        for (int e = 0; e < 8; ++e) { const float d = v[e] - mean; q += d * d; }
        const float rstd = rsqrtf(wave_sum(q, lane) * (1.0f / 512.0f) + EPS);
        if (lane == 0) { st[2 * j] = mean; st[2 * j + 1] = rstd; }
    }
    __syncthreads();
    {
        const int c = tid; const float g = lng[c], b = lnb[c];
        const bf16_t* src = PROJ + proj_off(tc, C_SV + c);
#pragma unroll 1
        for (int jb = 0; jb < 4; ++jb) {
            bf16_t rv[32];
#pragma unroll
            for (int e = 0; e < 32; ++e) rv[e] = src[(32 * jb + e) * 64];
#pragma unroll
            for (int jg = 0; jg < 4; ++jg) {
                float vn[8];
#pragma unroll
                for (int e = 0; e < 8; ++e) { const int j = 32 * jb + 8 * jg + e; vn[e] = (bf2f(rv[8 * jg + e]) - st[2 * j]) * st[2 * j + 1] * g + b; }
                u32x4 o; o.x = cvt_pk_bf16(vn[0], vn[1]); o.y = cvt_pk_bf16(vn[2], vn[3]); o.z = cvt_pk_bf16(vn[4], vn[5]); o.w = cvt_pk_bf16(vn[6], vn[7]);
                *(LAS u32x4*)(Vt + c * SG_P + 32 * jb + 8 * jg) = o;
            }
        }
    }
    __syncthreads();
    const int fr = lane & 15, fq = lane >> 4, irow = 16 * wave + fr, nks = (wave >> 1) + 1;
    f32x4 outv[8][4]; float ssq = 0.f;
    bf16x8 wa[2][4]; u32x2 ub[2][4]; float bs[2];
#define SGU_LOAD(buf, hh_) do { int hr = (hh_); asm volatile("" : "+s"(hr)); const bf16_t* swh = SW + ((size_t)(hr * 128 + irow) * 128 + 8 * fq); \
        _Pragma("unroll") for (int ks = 0; ks < 4; ++ks) wa[buf][ks] = *(const bf16x8*)(swh + 32 * ks); \
        const bf16_t* up = PROJ + proj_off(tc + irow, C_SU + hr * 64 + 4 * fq); \
        _Pragma("unroll") for (int nt = 0; nt < 4; ++nt) ub[buf][nt] = *(const u32x2*)(up + 16 * nt); \
        bs[buf] = sb[hr * 128 + irow]; } while (0)
    SGU_LOAD(0, 0);
#pragma unroll
    for (int h = 0; h < 8; ++h) {
        if (h < 7) SGU_LOAD((h + 1) & 1, h + 1);
        int hr = h; asm volatile("" : "+s"(hr));
        f32x4 acc[4];
#pragma unroll
        for (int nt = 0; nt < 4; ++nt) acc[nt] = (f32x4){0.f, 0.f, 0.f, 0.f};
        const LAS bf16_t* vth = Vt + (hr * 64 + fr) * SG_P + 8 * fq;
#pragma unroll
        for (int ks = 0; ks < 4; ++ks) if (ks < nks) {
#pragma unroll
            for (int nt = 0; nt < 4; ++nt) { const bf16x8 bf = *(const LAS bf16x8*)(vth + 16 * nt * SG_P + 32 * ks);
                acc[nt] = __builtin_amdgcn_mfma_f32_16x16x32_bf16(bf, wa[h & 1][ks], acc[nt], 0, 0, 0); }
        }
        const float bias = bs[h & 1];
#pragma unroll
        for (int nt = 0; nt < 4; ++nt) {
            const u32x2 ur = ub[h & 1][nt];
            f32x4 u; u[0] = __uint_as_float(ur.x << 16); u[1] = __uint_as_float(ur.x & 0xffff0000u); u[2] = __uint_as_float(ur.y << 16); u[3] = __uint_as_float(ur.y & 0xffff0000u);
            const f32x4 o = u * (acc[nt] + bias); outv[h][nt] = o; ssq += (o[0] * o[0] + o[1] * o[1]) + (o[2] * o[2] + o[3] * o[3]);
        }
    }
#undef SGU_LOAD
    ssq += shx(ssq, 16, lane); ssq += shx(ssq, 32, lane);
    const float r2 = rsqrtf(ssq * (1.0f / 512.0f) + EPS);
    int orow_r = tc + irow; asm volatile("" : "+v"(orow_r));
    bf16_t* orow = MIX + blk_off(orow_r, X_SGU + 4 * fq);
#pragma unroll
    for (int h = 0; h < 8; ++h)
#pragma unroll
        for (int nt = 0; nt < 4; ++nt) { const f32x4 o = outv[h][nt] * r2; u32x2 w; w.x = cvt_pk_bf16(o[0], o[1]); w.y = cvt_pk_bf16(o[2], o[3]); *(u32x2*)(orow + h * (256 * 64) + 16 * nt) = w; }
}

constexpr int AT_KP = 144, AT_VP = 520;
constexpr float LOG2E = 1.4426950408889634f;
__device__ __forceinline__ void attn_unit(LAS unsigned char* lds, int unit, const bf16_t* PROJ, bf16_t* MIX, float* AST, const float* gq, const float* gk, const float* sinks, int tid_in) {
    int tid = tid_in; asm volatile("" : "+v"(tid));
    const int lane = tid & 63, wave = __builtin_amdgcn_readfirstlane(tid >> 6);
    const int kvh = unit & 3, blk = (unit >> 2) & 15, b = unit >> 6;
    const int tb = b * SEQ + blk * 128, kb = tb - 128, jmin = blk == 0 ? 128 : 0;
    LAS unsigned char* Ks = lds; LAS unsigned char* Vt = lds + 256 * AT_KP; LAS float* ssx = (LAS float*)(lds + 256 * AT_KP + 64 * AT_VP);
    __syncthreads();
#pragma unroll
    for (int it = 0; it < 4; ++it) {
        const int idx = tid + 512 * it, kr = idx >> 3, c8 = idx & 7; const bool valid = kr >= jmin; const int row = valid ? kb + kr : tb;
        const u32x4 raw = *(const u32x4*)(PROJ + proj_off(row, C_K + kvh * 64 + c8 * 8));
        float v[8];
#pragma unroll
        for (int e = 0; e < 4; ++e) { v[2 * e] = __uint_as_float(raw[e] << 16); v[2 * e + 1] = __uint_as_float(raw[e] & 0xffff0000u); }
        float ss = 0.f;
#pragma unroll
        for (int e = 0; e < 8; ++e) ss += v[e] * v[e];
        ss += shx(ss, 1, lane); ss += shx(ss, 2, lane); ss += shx(ss, 4, lane);
        const float rk = valid ? rsqrtf(ss * (1.0f / 64.0f) + EPS) : 0.f;
        const f32x4 ga = *(const f32x4*)(gk + c8 * 8), gb = *(const f32x4*)(gk + c8 * 8 + 4);
        u32x4 o; o.x = cvt_pk_bf16(v[0] * rk * ga[0], v[1] * rk * ga[1]); o.y = cvt_pk_bf16(v[2] * rk * ga[2], v[3] * rk * ga[3]);
        o.z = cvt_pk_bf16(v[4] * rk * gb[0], v[5] * rk * gb[1]); o.w = cvt_pk_bf16(v[6] * rk * gb[2], v[7] * rk * gb[3]);
        *(LAS u32x4*)(Ks + kr * AT_KP + c8 * 16) = o;
    }
#pragma unroll
    for (int it = 0; it < 8; ++it) {
        const int idx = tid + 512 * it, d = idx & 63, kg = idx >> 6;
        unsigned short x[4];
#pragma unroll
        for (int e = 0; e < 4; ++e) { const int key = 4 * kg + e; const bool valid = key >= jmin; const int row = valid ? kb + key : tb;
            const bf16_t r = PROJ[proj_off(row, C_V + kvh * 64 + d)]; x[e] = valid ? r : (bf16_t)0; }
        u32x2 o; o.x = (unsigned)x[0] | ((unsigned)x[1] << 16); o.y = (unsigned)x[2] | ((unsigned)x[3] << 16);
        *(LAS u32x2*)(Vt + d * AT_VP + kg * 8) = o;
    }
    __syncthreads();
    const int g = wave >> 1, half = wave & 1, h = kvh * 4 + g, q = lane & 31, hh = lane >> 5;
    const float sink2 = sinks[h] * LOG2E;
    u32x4 qraw[2][4];
#pragma unroll
    for (int qt = 0; qt < 2; ++qt) { const bf16_t* qp = PROJ + proj_off(tb + half * 64 + qt * 32 + q, C_Q + h * 64 + 8 * hh);
#pragma unroll
        for (int ks = 0; ks < 4; ++ks) qraw[qt][ks] = *(const u32x4*)(qp + 16 * ks); }
#pragma unroll
    for (int qt = 0; qt < 2; ++qt) {
        const int i0 = half * 64 + qt * 32, i = i0 + q, kt0 = i0 >> 5;
        bf16x8 qf[4];
        {
            float ss = 0.f;
#pragma unroll
            for (int ks = 0; ks < 4; ++ks) {
#pragma unroll
                for (int e = 0; e < 4; ++e) { const float a = __uint_as_float(qraw[qt][ks][e] << 16), c = __uint_as_float(qraw[qt][ks][e] & 0xffff0000u); ss += a * a + c * c; } }
            ss += shx(ss, 32, lane);
            const float rq = rsqrtf(ss * (1.0f / 64.0f) + EPS) * (0.125f * LOG2E);
#pragma unroll
            for (int ks = 0; ks < 4; ++ks) { const f32x4 ga = *(const f32x4*)(gq + 16 * ks + 8 * hh), gb = *(const f32x4*)(gq + 16 * ks + 8 * hh + 4);
                u32x4 o;
#pragma unroll
                for (int e = 0; e < 4; ++e) { const float a = __uint_as_float(qraw[qt][ks][e] << 16), c = __uint_as_float(qraw[qt][ks][e] & 0xffff0000u);
                    const float g0 = e < 2 ? ga[2 * e] : gb[2 * e - 4], g1 = e < 2 ? ga[2 * e + 1] : gb[2 * e - 3]; o[e] = cvt_pk_bf16(a * rq * g0, c * rq * g1); }
                qf[ks] = __builtin_bit_cast(bf16x8, o); }
        }
        f32x16 S[5];
        const LAS unsigned char* kp = Ks + (32 * kt0 + q) * AT_KP + 16 * hh;
#pragma unroll
        for (int kt = 0; kt < 5; ++kt) {
#pragma unroll
            for (int r = 0; r < 16; ++r) S[kt][r] = 0.f;
#pragma unroll
            for (int ks = 0; ks < 4; ++ks) { const bf16x8 kf = *(const LAS bf16x8*)(kp + kt * 32 * AT_KP + ks * 32);
                S[kt] = __builtin_amdgcn_mfma_f32_32x32x16_bf16(kf, qf[ks], S[kt], 0, 0, 0); }
        }
        float mx = -1e30f; const int qa = q - 4 * hh;
#pragma unroll
        for (int kt = 0; kt < 5; ++kt) { const bool tv = 32 * (kt0 + kt) >= jmin;
#pragma unroll
            for (int r = 0; r < 16; ++r) { const int kl = (r & 3) + 8 * (r >> 2);
                bool ok = tv; if (kt == 0) ok = ok && (kl > qa); if (kt == 4) ok = ok && (kl <= qa);
                const float sv = ok ? S[kt][r] : -1e30f; S[kt][r] = sv; mx = fmaxf(mx, sv); } }
        mx = fmaxf(mx, shx(mx, 32, lane)); mx = fmaxf(mx, sink2);
        float sum = 0.f;
#pragma unroll
        for (int kt = 0; kt < 5; ++kt)
#pragma unroll
            for (int r = 0; r < 16; ++r) { const float p = __builtin_amdgcn_exp2f(S[kt][r] - mx); S[kt][r] = p; sum += p; }
        sum += shx(sum, 32, lane);
        const float inv = __builtin_amdgcn_rcpf(sum + __builtin_amdgcn_exp2f(sink2 - mx));
        f32x16 O[2];
#pragma unroll
        for (int r = 0; r < 16; ++r) { O[0][r] = 0.f; O[1][r] = 0.f; }
        const LAS unsigned char* vp = Vt + q * AT_VP + (32 * kt0 + 4 * hh) * 2;
#pragma unroll
        for (int kt = 0; kt < 5; ++kt)
#pragma unroll
            for (int s2 = 0; s2 < 2; ++s2) {
                u32x4 pw; pw.x = cvt_pk_bf16(S[kt][8 * s2 + 0], S[kt][8 * s2 + 1]); pw.y = cvt_pk_bf16(S[kt][8 * s2 + 2], S[kt][8 * s2 + 3]);
                pw.z = cvt_pk_bf16(S[kt][8 * s2 + 4], S[kt][8 * s2 + 5]); pw.w = cvt_pk_bf16(S[kt][8 * s2 + 6], S[kt][8 * s2 + 7]);
                const bf16x8 pf = __builtin_bit_cast(bf16x8, pw);
#pragma unroll
                for (int dt = 0; dt < 2; ++dt) {
                    const u32x2 lo = *(const LAS u32x2*)(vp + dt * 32 * AT_VP + (32 * kt + 16 * s2) * 2), hi2 = *(const LAS u32x2*)(vp + dt * 32 * AT_VP + (32 * kt + 16 * s2 + 8) * 2);
                    u32x4 vw; vw.x = lo.x; vw.y = lo.y; vw.z = hi2.x; vw.w = hi2.y;
                    O[dt] = __builtin_amdgcn_mfma_f32_32x32x16_bf16(__builtin_bit_cast(bf16x8, vw), pf, O[dt], 0, 0, 0);
                }
            }
        float ssq = 0.f;
        bf16_t* op = MIX + blk_off(tb + i, X_ATT + h * 64 + 4 * hh);
#pragma unroll
        for (int dt = 0; dt < 2; ++dt)
#pragma unroll
            for (int g4 = 0; g4 < 4; ++g4) { float o0 = O[dt][4 * g4] * inv, o1 = O[dt][4 * g4 + 1] * inv, o2 = O[dt][4 * g4 + 2] * inv, o3 = O[dt][4 * g4 + 3] * inv;
                ssq += (o0 * o0 + o1 * o1) + (o2 * o2 + o3 * o3); u32x2 w; w.x = cvt_pk_bf16(o0, o1); w.y = cvt_pk_bf16(o2, o3); *(u32x2*)(op + 32 * dt + 8 * g4) = w; }
        ssq += shx(ssq, 32, lane);
        if (hh == 0) ssx[g * 128 + i] = ssq;
    }
    __syncthreads();
    if (tid < 128) AST[(size_t)(tb + tid) * 4 + kvh] = (ssx[tid] + ssx[128 + tid]) + (ssx[256 + tid] + ssx[384 + tid]);
}

constexpr int I_IN = (DM / 64) * (DIN / 64), I_OUT = (DM / 64) * (DM / 64), I_UP = (DM / 64) * (DFF / 64), I_DN = (DFF / 64) * (DM / 64), I_L = I_IN + I_OUT + I_UP + I_DN;
__device__ __forceinline__ void convert_range(const Args& args, unsigned char* ws, int l, int lo_item, int hi_item, int gwi, int ngw, LAS float* scr, int lane) {
    for (int it = lo_item + gwi; it < hi_item; it += ngw) {
        int r = it;
        if (r < I_IN) { p0_transpose_item(args.in[2] + (size_t)l * DM * DIN, args.in[1] + l * DM, DM, DIN, (bf16_t*)(ws + WS_WIN + l * SZ_WIN), scr, r, lane); continue; } r -= I_IN;
        if (r < I_OUT) { p0_transpose_item(args.in[15] + (size_t)l * DM * DM, args.in[14] + l * DM, DM, DM, (bf16_t*)(ws + WS_WOUT + l * SZ_WOUT), scr, r, lane); continue; } r -= I_OUT;
        if (r < I_UP) { p0_transpose_item(args.in[17] + (size_t)l * DM * DFF, args.in[16] + l * DM, DM, DFF, (bf16_t*)(ws + WS_WUP + l * SZ_WUP), scr, r, lane); continue; } r -= I_UP;
        p0_transpose_item(args.in[18] + (size_t)l * DFF * DM, nullptr, DFF, DM, (bf16_t*)(ws + WS_WDN + l * SZ_WDN), scr, r, lane);
    }
}

#define XB_TMO      128
#define XB_XCNT(j)  (256  + 64 * (j))
#define XB_XSUB(j)  (1280 + 64 * (j))
#define XB_XGEN(j)  (2304 + 64 * (j))
#define XB_TOP      3328
#define XB_TOPGEN   3392
#define XCD_BAR_WORDS 3456
#define XB_SPIN_CAP (1u << 18)
__device__ __forceinline__ unsigned xb_ld(unsigned* p)              { return __hip_atomic_load(p, __ATOMIC_RELAXED, __HIP_MEMORY_SCOPE_AGENT); }
__device__ __forceinline__ unsigned xb_add(unsigned* p, unsigned v) { return __hip_atomic_fetch_add(p, v, __ATOMIC_RELAXED, __HIP_MEMORY_SCOPE_AGENT); }
__device__ __forceinline__ unsigned xb_xcc_id() { return (unsigned)__builtin_amdgcn_s_getreg((3 << 11) | 20) & 0xFu; }
#define XB_SPIN(cond, bar) do { unsigned _sp = 0; while (cond) { __builtin_amdgcn_s_sleep(1); \
    if ((++_sp & 255u) == 0u) { if (xb_ld(&(bar)[XB_TMO])) break; if (_sp > XB_SPIN_CAP) { atomicAdd(&(bar)[XB_TMO], 1u); break; } } } } while (0)
struct XcdBarrier { unsigned* bar; unsigned x; volatile LAS unsigned* st; };
__device__ __forceinline__ XcdBarrier xcd_barrier_post(unsigned* bar, volatile LAS unsigned* st) {
    XcdBarrier b; b.bar = bar; b.x = xb_xcc_id(); b.st = st;
    if (threadIdx.x == 0) (void)xb_add(&bar[XB_XCNT(b.x)], 1u);
    return b;
}
__device__ __forceinline__ void xcd_barrier_complete(unsigned* bar, unsigned x, unsigned& nloc, unsigned& nx) {
    const unsigned G = gridDim.x * gridDim.y * gridDim.z;
    unsigned sum, cnt, mine, sp = 0u;
    for (;;) {
        sum = 0u; cnt = 0u; mine = 0u;
#pragma unroll
        for (unsigned j = 0; j < 16; ++j) { const unsigned c = xb_ld(&bar[XB_XCNT(j)]); sum += c; cnt += (c > 0u) ? 1u : 0u; mine = (j == x) ? c : mine; }
        if (sum == G) break;
        __builtin_amdgcn_s_sleep(1);
        if ((++sp & 255u) == 0u) { if (xb_ld(&bar[XB_TMO])) break; if (sp > XB_SPIN_CAP) { atomicAdd(&bar[XB_TMO], 1u); break; } }
    }
    nloc = mine > 0u ? mine : 1u; nx = cnt > 0u ? cnt : 1u;
}
__device__ __forceinline__ void xcd_barrier(const XcdBarrier& b, int wave_s) {
    asm volatile("s_waitcnt vmcnt(0)" ::: "memory");
    __syncthreads();
    if (wave_s == 0 && lane_id() == 0) {
        unsigned* bar = b.bar;
        __builtin_amdgcn_s_waitcnt(0);
        unsigned nloc = b.st[0], nx = b.st[1];
        if (nloc == 0u) { xcd_barrier_complete(bar, b.x, nloc, nx); b.st[0] = nloc; b.st[1] = nx; }
        const unsigned old = xb_add(&bar[XB_XSUB(b.x)], 1u);
        const unsigned gen = old / nloc;
        if (old + 1u == (gen + 1u) * nloc) {
            __builtin_amdgcn_fence(__ATOMIC_RELEASE, "agent");
            asm volatile("s_waitcnt vmcnt(0)" ::: "memory");
            const unsigned og = xb_add(&bar[XB_TOP], 1u);
            const unsigned tg = og / nx;
            if (og + 1u == (tg + 1u) * nx) xb_add(&bar[XB_TOPGEN], 1u);
            else XB_SPIN(xb_ld(&bar[XB_TOPGEN]) == tg, bar);
            __builtin_amdgcn_fence(__ATOMIC_ACQUIRE, "agent");
            xb_add(&bar[XB_XGEN(b.x)], 1u);
            asm volatile("s_waitcnt vmcnt(0)" ::: "memory");
        } else {
            XB_SPIN(xb_ld(&bar[XB_XGEN(b.x)]) == gen, bar);
            __builtin_amdgcn_fence(__ATOMIC_ACQUIRE, "agent");
            asm volatile("s_waitcnt vmcnt(0)" ::: "memory");
        }
    }
    __syncthreads();
}

__global__ void __launch_bounds__(NTHREADS, 2) fwd(Args args) {
    extern __shared__ __attribute__((aligned(16))) unsigned char lds_raw[];
    LAS unsigned char* lds = (LAS unsigned char*)lds_raw;
    const int tid = threadIdx.x, lane = tid & 63, wave = __builtin_amdgcn_readfirstlane(tid >> 6);
    const int G = gridDim.x, bx = blockIdx.x;
    const int gw = bx * NWAVES + wave, NGW = G * NWAVES;
    unsigned char* ws = args.ws;
    bf16_t* XB = (bf16_t*)(ws + WS_XB); bf16_t* PROJ = (bf16_t*)(ws + WS_PROJ); bf16_t* MIX = (bf16_t*)(ws + WS_MIX); bf16_t* HB = (bf16_t*)(ws + WS_H);
    float* RSA = (float*)(ws + WS_RSA); float* RSB = (float*)(ws + WS_RSB); float* AST = (float*)(ws + WS_AST);
    const int lo = args.ph_lo, hi = args.ph_hi;
    const bool split = (G == 256) && (DEPTH == 2);
#if MK_ONE_LAUNCH
    cg::grid_group grid = cg::this_grid();
    volatile LAS unsigned* MISC = (volatile LAS unsigned*)(lds + LDS_BYTES - 64);
    if (tid < 16) MISC[tid] = 0u;
    __syncthreads();
    const XcdBarrier xbar = xcd_barrier_post((unsigned*)(ws + WS_BAR), MISC);
    if (hi > 1000) grid.sync();
#define SEAM(k) do { if ((k) + 1 < hi) xcd_barrier(xbar, wave); } while (0)
#else
#define SEAM(k) do { } while (0)
#endif
#define IN(k) (lo <= (k) && (k) < hi)

    if (IN(0)) {
        LAS float* scr = (LAS float*)(lds + wave * 16640);
        convert_range(args, ws, 0, 0, I_L, gw, NGW, scr, lane);
        if (!split) convert_range(args, ws, 1, 0, I_L, gw, NGW, scr, lane);
        for (int i = bx * NTHREADS + tid; i < DEPTH * 8 * 128 * 128; i += G * NTHREADS) {
            const int ii = (i >> 7) & 127, jj = i & 127; ((bf16_t*)(ws + WS_SGUW))[i] = jj <= ii ? f2bf(args.in[12][i]) : (bf16_t)0; }
        const float* x = args.in[0];
        for (int m = 2 * gw; m < M; m += 2 * NGW) {
            const f32x4* xr = (const f32x4*)(x + (size_t)m * DM) + lane; f32x4 v[16];
#pragma unroll
            for (int j = 0; j < 16; ++j) v[j] = xr[64 * j];
            float ss0 = 0.f, ss1 = 0.f;
#pragma unroll
            for (int j = 0; j < 16; ++j) { const float q = (v[j][0] * v[j][0] + v[j][1] * v[j][1]) + (v[j][2] * v[j][2] + v[j][3] * v[j][3]); if (j < 8) ss0 += q; else ss1 += q;
                u32x2 w; w.x = cvt_pk_bf16(v[j][0], v[j][1]); w.y = cvt_pk_bf16(v[j][2], v[j][3]); *(u32x2*)(XB + blk_off(m + (j >> 3), 4 * lane + 256 * (j & 7))) = w; }
            ss0 = wave_sum(ss0, lane); ss1 = wave_sum(ss1, lane); if (lane == 0) { RSA[m] = ss0; RSA[m + 1] = ss1; }
        }
        SEAM(0);
    }
    for (int l = 0; l < DEPTH; ++l) {
        const int pb = 1 + 5 * l;
        if (IN(pb)) {
            pg8::Gemm g{XB, (const bf16_t*)(ws + WS_WIN + l * SZ_WIN), M, DIN, DM}; pg8::StaticOrder S; S.init(M, DIN, G, bx);
            pg8::EpiScaleBf16<0, true> E{PROJ, DIN, RSA + (size_t)l * M, 1.0f / DM};
            pg8::gemm_phase<pg8::EpiScaleBf16<0, true>, true, true, true>(lds, g, S, E, wave);
            if (split && bx >= 128) {
                int t_ = wave * 64 + lane_id(); asm volatile("" : "+v"(t_));
                LAS float* scr = (LAS float*)(lds + wave * 16640);
                if (l == 0) convert_range(args, ws, 1, 0, I_IN + I_OUT + I_UP, (bx - 128) * NWAVES + wave, 128 * NWAVES, scr, t_ & 63);
                else convert_range(args, ws, 1, I_IN + I_OUT + I_UP, I_L, (bx - 128) * NWAVES + wave, 128 * NWAVES, scr, t_ & 63);
            }
            SEAM(pb);
        }
        if (IN(pb + 1)) {
            int t_ = wave * 64 + lane_id(); asm volatile("" : "+v"(t_));
            for (int u = bx; u < 512; u += G) attn_unit(lds, u, PROJ, MIX, AST, args.in[3] + l * 64, args.in[4] + l * 64, args.in[5] + l * 16, t_);
            for (int u = bx; u < 256; u += G) {
                if (u < 128) sgu_unit(lds, u, PROJ, MIX, (const bf16_t*)(ws + WS_SGUW + l * SZ_SGUW), args.in[10] + l * 512, args.in[11] + l * 512, args.in[13] + l * 8 * 128, t_);
                else { conv_unit(lds, 2 * (u - 128), PROJ, MIX, args.in[6] + l * 31 * 512, args.in[7] + l * 512, args.in[8] + l * 512, args.in[9] + l * 512, t_);
                       conv_unit(lds, 2 * (u - 128) + 1, PROJ, MIX, args.in[6] + l * 31 * 512, args.in[7] + l * 512, args.in[8] + l * 512, args.in[9] + l * 512, t_); }
            }
            SEAM(pb + 1);
        }
        if (IN(pb + 2)) {
            pg8::Gemm g{MIX, (const bf16_t*)(ws + WS_WOUT + l * SZ_WOUT), M, DM, DM}; pg8::StaticOrder S; S.init(M, DM, G, bx);
            pg8::EpiRes<16, false> E{XB, nullptr, RSB + (size_t)l * M, AST, DM};
            pg8::gemm_phase<pg8::EpiRes<16, false>, true, true, true>(lds, g, S, E, wave);
            SEAM(pb + 2);
        }
        if (IN(pb + 3)) {
            pg8::Gemm g{XB, (const bf16_t*)(ws + WS_WUP + l * SZ_WUP), M, DFF, DM}; pg8::StaticOrder S; S.init(M, DFF, G, bx, 3);
            pg8::EpiScaleBf16<1, true> E{HB, DFF, RSB + (size_t)l * M, 1.0f / DM};
            pg8::gemm_phase<pg8::EpiScaleBf16<1, true>, true, true, true>(lds, g, S, E, wave);
            SEAM(pb + 3);
        }
        if (IN(pb + 4)) {
            pg8::Gemm g{HB, (const bf16_t*)(ws + WS_WDN + l * SZ_WDN), M, DM, DFF}; pg8::StaticOrder S; S.init(M, DM, G, bx, 1);
            if (l == DEPTH - 1) { pg8::EpiRes<0, true> E{XB, args.out, nullptr, nullptr, DM}; pg8::gemm_phase<pg8::EpiRes<0, true>, true, true, true>(lds, g, S, E, wave); }
            else { pg8::EpiRes<0, false> E{XB, nullptr, RSA + (size_t)(l + 1) * M, nullptr, DM}; pg8::gemm_phase<pg8::EpiRes<0, false>, true, true, true>(lds, g, S, E, wave); }
            SEAM(pb + 4);
        }
    }
#undef IN
#undef SEAM
}

constexpr int NPHASES = 1 + 5 * DEPTH;

extern "C" void kernel_launch(void* const* d_in, const int* in_sizes, int n_in, void* d_out, int out_size, void* d_ws, size_t ws_size, hipStream_t stream) {
    static int grid = 0;
    if (grid == 0) {
        if (n_in != 19 || in_sizes[0] != M * DM || out_size != M * DM || ws_size < WS_END) {
            fprintf(stderr, "kernel_launch: unexpected shapes (n_in %d, in0 %d, out %d, ws %zu need %zu); nothing launched\n", n_in, n_in > 0 ? in_sizes[0] : -1, out_size, ws_size, (size_t)WS_END); grid = -1; return; }
        int dev = 0, cus = 0, per_cu = 0;
        (void)hipGetDevice(&dev); (void)hipDeviceGetAttribute(&cus, hipDeviceAttributeMultiprocessorCount, dev);
        if (hipFuncSetAttribute((const void*)fwd, hipFuncAttributeMaxDynamicSharedMemorySize, LDS_BYTES) != hipSuccess) { fprintf(stderr, "kernel_launch: hipFuncSetAttribute failed\n"); grid = -1; return; }
        (void)hipOccupancyMaxActiveBlocksPerMultiprocessor(&per_cu, (const void*)fwd, NTHREADS, LDS_BYTES);
        if (per_cu < 1) fprintf(stderr, "kernel_launch: occupancy query says %d blocks per CU\n", per_cu);
        (void)hipGetLastError();
        grid = cus > 0 ? cus : 256;
    }
    if (grid < 0) return;
    (void)hipMemsetAsync((unsigned char*)d_ws + WS_BAR, 0, 16384 + (size_t)(2 * DEPTH) * M * 4, stream);
    Args a{};
    for (int i = 0; i < 19; ++i) a.in[i] = (const float*)d_in[i];
    a.out = (float*)d_out; a.ws = (unsigned char*)d_ws;
#if MK_ONE_LAUNCH
    a.ph_lo = 0; a.ph_hi = NPHASES;
    void* kargs[] = {&a};
    hipError_t e = hipLaunchCooperativeKernel((const void*)fwd, dim3(grid), dim3(NTHREADS), kargs, LDS_BYTES, stream);
    if (e != hipSuccess) fprintf(stderr, "cooperative launch failed: %s (grid %d)\n", hipGetErrorString(e), grid);
#else
    for (int p = 0; p < NPHASES; ++p) {
        a.ph_lo = p; a.ph_hi = p + 1;
        hipLaunchKernelGGL(fwd, dim3(grid), dim3(NTHREADS), LDS_BYTES, stream, a);
    }
#endif
}
```
